# Optimizing an MI355X kernel written in HIP

```python
import math
import jax, jax.numpy as jnp
from jax import lax
import numpy as np

D_MODEL = 1024
BATCH = 2
SEQ = 16384
DEPTH = 2

N_MIXERS = 2
ATTN_HEADS = 8
ATTN_HEAD_DIM = D_MODEL // ATTN_HEADS // 2
ATTN_V_DIM = 2 * ATTN_HEAD_DIM
Q_BLOCK = 128
SGU_WIDTH = 2 * D_MODEL
SGU_GROUPS = 8
SGU_GROUP_DIM = SGU_WIDTH // SGU_GROUPS
CHUNK = 128
FFN_DIM = 2816
CONV_WIDTH = 3
NORM_EPS = 1e-6
LN_EPS = 1e-5

N_ATTN_LAYERS = (DEPTH + N_MIXERS - 1) // N_MIXERS
N_SGU_LAYERS = DEPTH // N_MIXERS

kernel_name = "hybrid_diffattn_chunksgu_convffn"


def _alibi_slopes(n_heads):
    return jnp.asarray(2.0 ** (-8.0 * np.arange(1, n_heads + 1) / n_heads), dtype=jnp.float32)


def rms_norm(x, gain):
    xf = x.astype(jnp.float32)
    y = xf * lax.rsqrt(jnp.mean(xf * xf, axis=-1, keepdims=True) + NORM_EPS) * gain.astype(jnp.float32)
    return y.astype(x.dtype)


def diff_attention(h, w_qkv, lq1, lk1, lq2, lk2, subln, w_o, layer_idx):
    B, S, _ = h.shape
    H, DH, VD = ATTN_HEADS, ATTN_HEAD_DIM, ATTN_V_DIM
    qkv = h @ w_qkv
    q, k, v = jnp.split(qkv, [H * 2 * DH, 2 * H * 2 * DH], axis=-1)
    q = q.reshape(B, S, H, 2, DH).transpose(0, 2, 3, 1, 4)
    k = k.reshape(B, S, H, 2, DH).transpose(0, 2, 3, 1, 4)
    v = v.reshape(B, S, H, VD).transpose(0, 2, 1, 3)

    lam_init = 0.8 - 0.6 * math.exp(-0.3 * layer_idx)
    f32 = jnp.float32
    lam = (jnp.exp(jnp.sum(lq1.astype(f32) * lk1.astype(f32)))
           - jnp.exp(jnp.sum(lq2.astype(f32) * lk2.astype(f32))) + lam_init)
    slopes = _alibi_slopes(H)
    s_pos = jnp.arange(S)
    n_qb = S // Q_BLOCK
    q_blocks = q.reshape(B, H, 2, n_qb, Q_BLOCK, DH).transpose(3, 0, 1, 2, 4, 5)
    scale = DH ** -0.5

    def one_block(args):
        qb, bi = args
        t_pos = bi * Q_BLOCK + jnp.arange(Q_BLOCK)
        dist = (t_pos[:, None] - s_pos[None, :]).astype(f32)
        bias = jnp.where(dist[None] >= 0, -slopes[:, None, None] * dist[None], -jnp.inf)
        scores = jnp.einsum('bhmqd,bhmkd->bhmqk', qb, k).astype(f32) * scale + bias[None, :, None]
        p = jax.nn.softmax(scores, axis=-1)
        p_diff = p[:, :, 0] - lam * p[:, :, 1]
        o = jnp.einsum('bhqk,bhkd->bhqd', p_diff.astype(v.dtype), v)
        return rms_norm(o, subln) * (1.0 - lam_init)

    out = lax.map(one_block, (q_blocks, jnp.arange(n_qb)))
    out = out.transpose(1, 0, 3, 2, 4).reshape(B, S, H * VD)
    return out @ w_o


def chunked_sgu(h, w_in, ln_g, ln_b, w_s, b_s, w_out):
    B, S, _ = h.shape
    z = jax.nn.gelu(h @ w_in)
    u, v = jnp.split(z, 2, axis=-1)
    vf = v.astype(jnp.float32)
    mu = jnp.mean(vf, axis=-1, keepdims=True)
    var = jnp.mean(jnp.square(vf - mu), axis=-1, keepdims=True)
    v = ((vf - mu) * lax.rsqrt(var + LN_EPS) * ln_g.astype(jnp.float32)
         + ln_b.astype(jnp.float32)).astype(h.dtype)
    n_c = S // CHUNK
    v = v.reshape(B, n_c, CHUNK, SGU_GROUPS, SGU_GROUP_DIM)
    causal = jnp.tril(jnp.ones((CHUNK, CHUNK), dtype=bool))
    w = jnp.where(causal[None], w_s, jnp.zeros_like(w_s))
    s = jnp.einsum('gts,bcsgd->bctgd', w, v) + b_s.T[None, None, :, :, None]
    y = u * s.reshape(B, S, SGU_WIDTH)
    return y @ w_out


def conv_ffn(h, w_up, conv_w, conv_b, w_down):
    a, g = jnp.split(h @ w_up, 2, axis=-1)
    S = a.shape[1]
    a_pad = jnp.pad(a, ((0, 0), (CONV_WIDTH - 1, 0), (0, 0)))
    a_conv = conv_b
    for j in range(CONV_WIDTH):
        a_conv = a_conv + a_pad[:, j:j + S] * conv_w[j]
    return (jax.nn.gelu(a_conv) * g) @ w_down


def setup_inputs(seed: int = 0) -> dict:
    key = jax.random.key(seed)
    ks = iter(jax.random.split(key, 32))
    f32 = jnp.float32
    D, E, F, G, C, DH = D_MODEL, SGU_WIDTH, FFN_DIM, SGU_GROUPS, CHUNK, ATTN_HEAD_DIM
    NA, NG, L = N_ATTN_LAYERS, N_SGU_LAYERS, DEPTH

    def nrm(shape, scale):
        return jax.random.normal(next(ks), shape, f32) * scale

    def gain(shape):
        return 1.0 + nrm(shape, 0.05)

    return {
        "x": nrm((BATCH, SEQ, D), 1.0),
        "attn_w_qkv": nrm((NA, D, 3 * D), D ** -0.5),
        "attn_lambda_q1": nrm((NA, DH), 0.1),
        "attn_lambda_k1": nrm((NA, DH), 0.1),
        "attn_lambda_q2": nrm((NA, DH), 0.1),
        "attn_lambda_k2": nrm((NA, DH), 0.1),
        "attn_subln": gain((NA, ATTN_V_DIM)),
        "attn_w_o": nrm((NA, D, D), D ** -0.5),
        "sgu_w_in": nrm((NG, D, 2 * E), D ** -0.5),
        "sgu_ln_g": gain((NG, E)),
        "sgu_ln_b": nrm((NG, E), 0.02),
        "sgu_w_s": nrm((NG, G, C, C), C ** -0.5),
        "sgu_b_s": gain((NG, G, C)),
        "sgu_w_out": nrm((NG, E, D), E ** -0.5),
        "norm_mix_pre": gain((L, D)),
        "norm_mix_post": gain((L, D)),
        "norm_ffn_pre": gain((L, D)),
        "norm_ffn_post": gain((L, D)),
        "ffn_w_up": nrm((L, D, 2 * F), D ** -0.5),
        "ffn_conv_w": nrm((L, CONV_WIDTH, F), CONV_WIDTH ** -0.5),
        "ffn_conv_b": nrm((L, F), 0.02),
        "ffn_w_down": nrm((L, F, D), F ** -0.5),
    }


def reference(x, attn_w_qkv, attn_lambda_q1, attn_lambda_k1, attn_lambda_q2, attn_lambda_k2,
              attn_subln, attn_w_o, sgu_w_in, sgu_ln_g, sgu_ln_b, sgu_w_s, sgu_b_s, sgu_w_out,
              norm_mix_pre, norm_mix_post, norm_ffn_pre, norm_ffn_post,
              ffn_w_up, ffn_conv_w, ffn_conv_b, ffn_w_down):
    for i in range(DEPTH):
        j = i // N_MIXERS
        hn = rms_norm(x, norm_mix_pre[i])
        if i % N_MIXERS == 0:
            m = diff_attention(hn, attn_w_qkv[j], attn_lambda_q1[j], attn_lambda_k1[j],
                               attn_lambda_q2[j], attn_lambda_k2[j], attn_subln[j], attn_w_o[j], i)
        else:
            m = chunked_sgu(hn, sgu_w_in[j], sgu_ln_g[j], sgu_ln_b[j], sgu_w_s[j], sgu_b_s[j],
                            sgu_w_out[j])
        x = x + rms_norm(m, norm_mix_post[i])
        f = conv_ffn(rms_norm(x, norm_ffn_pre[i]), ffn_w_up[i], ffn_conv_w[i], ffn_conv_b[i],
                     ffn_w_down[i])
        x = x + rms_norm(f, norm_ffn_post[i])
    return x
```

```cpp
#include <hip/hip_runtime.h>
#include <hip/hip_cooperative_groups.h>
#include <cstdio>
#include <cstdint>
namespace cg = cooperative_groups;
namespace pg8 {
#define PG8_LAS __attribute__((address_space(3)))
typedef unsigned short bf16_t;
typedef short bf16x8 __attribute__((ext_vector_type(8)));
typedef float f32x4 __attribute__((ext_vector_type(4)));
typedef unsigned u32x4 __attribute__((ext_vector_type(4)));
constexpr int BM = 256, BK = 64, HALF = 128, HTB = HALF * BK * 2  , STAGE_BYTES = 8 * HTB, NXCD = 8, WGM = 8;

__host__ __device__ __forceinline__ int lds_byte(int r, int c) { const int st = (r >> 4) * 2 + (c >> 5), rr = r & 15, cc = c & 31, ob = rr * 64 + cc * 2; return st * 1024 + (ob ^ (((ob >> 9) & 1) << 5)); }
__host__ __device__ __forceinline__ void stage_rc(int b, int& R, int& C) { const int st = b / 1024, sb = b % 1024, swz = sb ^ (((sb >> 9) & 1) << 5); R = (st >> 1) * 16 + swz / 64; C = (st & 1) * 32 + (swz % 64) / 2; }
__host__ __device__ __forceinline__ int perm32(int rho) { const int n = rho >> 4, i = rho & 15; return 8 * (i >> 2) + 4 * n + (i & 3); }

struct Unit { int pm, pn; };
struct Gemm { const bf16_t* A; const bf16_t* Bt; int M, N, K; };

struct StaticOrder {
    int nM, nN, nwg, G, c;
    __host__ __device__ void init(int M, int N, int G_, int c_) { nM = M / BM; nN = N / BM; nwg = nM * nN; G = G_; c = c_; }
    __host__ __device__ bool next(int i, Unit& u) const {
        const long L = (long)i * G + c; if (L >= nwg) return false;
        int wgid = (int)L; { const int q = nwg / NXCD, r = nwg % NXCD, xcd = wgid % NXCD, off = wgid / NXCD; wgid = (xcd < r ? xcd * (q + 1) : r * (q + 1) + (xcd - r) * q) + off; }
        const int nig = WGM * nN, gid = wgid / nig, fm = gid * WGM, gsz = (nM - fm) < WGM ? (nM - fm) : WGM;
        u.pm = fm + ((wgid % nig) % gsz); u.pn = (wgid % nig) / gsz; return true;
    }
    __device__ __forceinline__ void a_ready(const Unit&) const {}
    __device__ __forceinline__ void done(const Unit&) const {}
};

__device__ __forceinline__ unsigned cvt_pk_bf16(float lo, float hi) { unsigned r; asm volatile("v_cvt_pk_bf16_f32 %0, %1, %2" : "=v"(r) : "v"(lo), "v"(hi)); return r; }
typedef float f32x2 __attribute__((ext_vector_type(2)));
__device__ __forceinline__ float gelu_tanh(float x) {
    const float e = __builtin_amdgcn_exp2f(-2.302208198f * x * (1.0f + 0.044715f * x * x));
    return x * __builtin_amdgcn_rcpf(1.0f + e);
}
template <int ACT> struct EpiB {
    static constexpr bool PERM = true, AFTER_DRAIN = false;
    bf16_t* O; int ldc; int split_cols; size_t split_stride; int scale_cols; float scale;
    __device__ __forceinline__ void operator()(const f32x4 (&acc)[2][2][4][2], const Unit& u, int wr, int wc, int fr, int fq) const {
        const int row0 = u.pm * BM + wr * 64 + fr; int colt = u.pn * BM; bf16_t* base = O;
        const float sc = (colt < scale_cols) ? scale : 1.f;
        if (split_cols) { const int t = colt / split_cols; base += (size_t)t * split_stride; colt -= t * split_cols; }
        const int col0 = colt + wc * 32 + 8 * fq;
#pragma unroll
        for (int ai = 0; ai < 2; ++ai)
#pragma unroll
            for (int m = 0; m < 4; ++m) { bf16_t* rowp = base + (size_t)(row0 + ai * HALF + m * 16) * ldc + col0;
#pragma unroll
                for (int bj = 0; bj < 2; ++bj) { f32x4 v0 = acc[ai][bj][m][0], v1 = acc[ai][bj][m][1];
                    if (ACT == 1) {
#pragma unroll
                        for (int e = 0; e < 4; ++e) { v0[e] = gelu_tanh(v0[e]); v1[e] = gelu_tanh(v1[e]); } }
                    v0 = v0 * sc; v1 = v1 * sc; u32x4 w; w.x = cvt_pk_bf16(v0[0], v0[1]); w.y = cvt_pk_bf16(v0[2], v0[3]); w.z = cvt_pk_bf16(v1[0], v1[1]); w.w = cvt_pk_bf16(v1[2], v1[3]);
                    *(u32x4*)(rowp + bj * HALF) = w; } }
    }
};
struct EpiF {
    static constexpr bool PERM = true, AFTER_DRAIN = false;
    float* O; int ldc;
    __device__ __forceinline__ void operator()(const f32x4 (&acc)[2][2][4][2], const Unit& u, int wr, int wc, int fr, int fq) const {
        const int row0 = u.pm * BM + wr * 64 + fr; const int col0 = u.pn * BM + wc * 32 + 8 * fq;
#pragma unroll
        for (int ai = 0; ai < 2; ++ai)
#pragma unroll
            for (int m = 0; m < 4; ++m) { float* rowp = O + (size_t)(row0 + ai * HALF + m * 16) * ldc + col0;
#pragma unroll
                for (int bj = 0; bj < 2; ++bj) { *(f32x4*)(rowp + bj * HALF) = acc[ai][bj][m][0]; *(f32x4*)(rowp + bj * HALF + 4) = acc[ai][bj][m][1]; } }
    }
};
template <class Epi, class Sched, bool ALIGN_EPI = false, bool SP2 = false>
__device__ __forceinline__ void gemm_phase(PG8_LAS unsigned char* lds, const Gemm g, const Sched& S, const Epi& E) {
    int tid_o = threadIdx.x; asm volatile("" : "+v"(tid_o));
    const int tid = tid_o, wid = __builtin_amdgcn_readfirstlane(tid >> 6), lane = tid & 63, wr = wid >> 2, wc = wid & 3, fr = lane & 15, fq = lane >> 4;
    const int K = g.K, nt = K / BK;
    unsigned voffA[2], voffB[2];
#pragma unroll
    for (int i = 0; i < 2; ++i) { int R, C; stage_rc(tid * 16 + i * 8192, R, C); const int Rb = Epi::PERM ? ((R & ~31) + perm32(R & 31)) : R;
        voffA[i] = (unsigned)(R * K + C) * 2u; voffB[i] = (unsigned)(Rb * K + C) * 2u; }
    const size_t kstep = (size_t)(BK * 2);
    const size_t hstep = (size_t)HALF * K * 2;
    const size_t tstep = 2 * hstep;
    const unsigned ldsw = (unsigned)wid * 1024u;
    const int aoff = lds_byte(wr * 64 + fr, fq * 8), boff = lds_byte(wc * 32 + fr, fq * 8);
#define PG8_SA(b, h) (((b) * 2 + (h)) * HTB)
#define PG8_SB(b, h) ((4 + (b) * 2 + (h)) * HTB)
#define PG8_STAGE(bufoff, gbase, voff) do { _Pragma("unroll") for (int _i = 0; _i < 2; ++_i) \
        __builtin_amdgcn_global_load_lds((const unsigned*)((const char*)(gbase) + (voff)[_i]), (PG8_LAS unsigned*)(lds + (bufoff) + ldsw + _i * 8192), 16, 0, 0); } while (0)
#define PG8_LDA(dst, b, h) do { _Pragma("unroll") for (int m = 0; m < 4; ++m) _Pragma("unroll") for (int k = 0; k < 2; ++k) dst[m][k] = *(const PG8_LAS bf16x8*)(lds + PG8_SA(b, h) + aoff + m * 2048 + k * 1024); } while (0)
#define PG8_LDB(dst, b, h) do { _Pragma("unroll") for (int n = 0; n < 2; ++n) _Pragma("unroll") for (int k = 0; k < 2; ++k) dst[n][k] = *(const PG8_LAS bf16x8*)(lds + PG8_SB(b, h) + boff + n * 2048 + k * 1024); } while (0)
#define PG8_MMA(ai, bj, At, Bt) do { __builtin_amdgcn_s_setprio(1); _Pragma("unroll") for (int m = 0; m < 4; ++m) _Pragma("unroll") for (int n = 0; n < 2; ++n) _Pragma("unroll") for (int k = 0; k < 2; ++k) \
        acc[ai][bj][m][n] = __builtin_amdgcn_mfma_f32_16x16x32_bf16(Bt[n][k], At[m][k], acc[ai][bj][m][n], 0, 0, 0); __builtin_amdgcn_s_setprio(0); } while (0)
#define PG8_WAIT_V(n) asm volatile("s_waitcnt vmcnt(" #n ")" ::: "memory")
#define PG8_WAIT_L(n) asm volatile("s_waitcnt lgkmcnt(" #n ")" ::: "memory")
#define PG8_BAR __builtin_amdgcn_s_barrier()
#define PG8_SCHED __builtin_amdgcn_sched_barrier(0)
    Unit cur, nxt; int ui = 0;
    if (!S.next(0, cur)) return;
    f32x4 acc[2][2][4][2];
#pragma unroll
    for (int a = 0; a < 2; ++a)
#pragma unroll
        for (int b = 0; b < 2; ++b)
#pragma unroll
            for (int m = 0; m < 4; ++m)
#pragma unroll
                for (int n = 0; n < 2; ++n) acc[a][b][m][n] = (f32x4){0.f, 0.f, 0.f, 0.f};
    bf16x8 At[4][2], B0[2][2], B1[2][2];
    const char* cA = (const char*)g.A + (size_t)cur.pm * tstep; const char* cB = (const char*)g.Bt + (size_t)cur.pn * tstep;
    S.a_ready(cur);
    if constexpr (SP2) {
        PG8_STAGE(PG8_SB(0, 0), cB, voffB); PG8_STAGE(PG8_SB(0, 1), cB + hstep, voffB); PG8_STAGE(PG8_SA(0, 0), cA, voffA); PG8_STAGE(PG8_SA(0, 1), cA + hstep, voffA);
        if (wr == 1) PG8_BAR;
        PG8_WAIT_V(2); PG8_BAR;
        PG8_STAGE(PG8_SB(1, 0), cB + kstep, voffB); PG8_STAGE(PG8_SA(1, 0), cA + kstep, voffA); PG8_STAGE(PG8_SB(1, 1), cB + hstep + kstep, voffB);
        PG8_WAIT_V(6); PG8_BAR;
    } else {
        PG8_STAGE(PG8_SB(0, 0), cB, voffB); PG8_STAGE(PG8_SA(0, 0), cA, voffA); PG8_STAGE(PG8_SB(0, 1), cB + hstep, voffB); PG8_STAGE(PG8_SA(0, 1), cA + hstep, voffA);
        if (wr == 1) PG8_BAR;
        PG8_WAIT_V(4); PG8_BAR;
        PG8_STAGE(PG8_SB(1, 0), cB + kstep, voffB); PG8_STAGE(PG8_SA(1, 0), cA + kstep, voffA); PG8_STAGE(PG8_SB(1, 1), cB + hstep + kstep, voffB);
        PG8_WAIT_V(6); PG8_BAR;
    }
    for (;;) {
        const bool has_next = S.next(ui + 1, nxt);
        const char* nA = has_next ? (const char*)g.A + (size_t)nxt.pm * tstep : cA; const char* nB = has_next ? (const char*)g.Bt + (size_t)nxt.pn * tstep : cB;
        for (int t = 0; t < nt; t += 2) {
            const bool last = (t == nt - 2);
            const char* a1 = cA + (size_t)(t + 1) * kstep;
            const char* a2 = last ? nA : cA + (size_t)(t + 2) * kstep; const char* b2 = last ? nB : cB + (size_t)(t + 2) * kstep;
            const char* a3 = a2 + kstep; const char* b3 = b2 + kstep;
            if (last && has_next) S.a_ready(nxt);
            if constexpr (SP2) {
            PG8_LDB(B0, 0, 0); PG8_LDB(B1, 0, 1); PG8_SCHED; PG8_LDA(At, 0, 0); PG8_STAGE(PG8_SA(1, 1), a1 + hstep, voffA);
            PG8_WAIT_V(8); PG8_WAIT_L(0); PG8_BAR; PG8_MMA(0, 0, At, B0); PG8_MMA(0, 1, At, B1); PG8_BAR; PG8_SCHED;
            PG8_LDA(At, 0, 1); PG8_STAGE(PG8_SB(0, 0), b2, voffB); PG8_STAGE(PG8_SB(0, 1), b2 + hstep, voffB); PG8_STAGE(PG8_SA(0, 0), a2, voffA);
            PG8_WAIT_V(8); PG8_WAIT_L(0); PG8_BAR; PG8_MMA(1, 0, At, B0); PG8_MMA(1, 1, At, B1); PG8_BAR; PG8_SCHED;
            PG8_LDB(B0, 1, 0); PG8_LDB(B1, 1, 1); PG8_SCHED; PG8_LDA(At, 1, 0); PG8_STAGE(PG8_SA(0, 1), a2 + hstep, voffA);
            PG8_WAIT_V(8); PG8_WAIT_L(0); PG8_BAR; PG8_MMA(0, 0, At, B0); PG8_MMA(0, 1, At, B1); PG8_BAR; PG8_SCHED;
            PG8_LDA(At, 1, 1); PG8_STAGE(PG8_SB(1, 0), b3, voffB); PG8_STAGE(PG8_SB(1, 1), b3 + hstep, voffB); PG8_STAGE(PG8_SA(1, 0), a3, voffA);
            PG8_WAIT_V(8); PG8_WAIT_L(0); PG8_BAR; PG8_MMA(1, 0, At, B0); PG8_MMA(1, 1, At, B1); PG8_BAR; PG8_SCHED;
            } else {
            PG8_LDB(B0, 0, 0); PG8_SCHED; PG8_LDA(At, 0, 0); PG8_STAGE(PG8_SA(1, 1), a1 + hstep, voffA);
            PG8_WAIT_L(8); PG8_BAR; PG8_WAIT_L(0); PG8_MMA(0, 0, At, B0); PG8_BAR; PG8_SCHED;
            PG8_LDB(B1, 0, 1); PG8_STAGE(PG8_SB(0, 0), b2, voffB);
            PG8_BAR; PG8_WAIT_L(0); PG8_MMA(0, 1, At, B1); PG8_BAR;
            PG8_LDA(At, 0, 1); PG8_STAGE(PG8_SA(0, 0), a2, voffA);
            PG8_BAR; PG8_WAIT_L(0); PG8_MMA(1, 0, At, B0); PG8_BAR; PG8_SCHED;
            PG8_STAGE(PG8_SB(0, 1), b2 + hstep, voffB);
            PG8_WAIT_V(6); PG8_BAR; PG8_MMA(1, 1, At, B1); PG8_BAR;
            PG8_LDB(B0, 1, 0); PG8_SCHED; PG8_LDA(At, 1, 0); PG8_STAGE(PG8_SA(0, 1), a2 + hstep, voffA);
            PG8_WAIT_L(8); PG8_BAR; PG8_WAIT_L(0); PG8_MMA(0, 0, At, B0); PG8_BAR; PG8_SCHED;
            PG8_LDB(B1, 1, 1); PG8_STAGE(PG8_SB(1, 0), b3, voffB);
            PG8_BAR; PG8_WAIT_L(0); PG8_MMA(0, 1, At, B1); PG8_BAR;
            PG8_LDA(At, 1, 1); PG8_STAGE(PG8_SA(1, 0), a3, voffA);
            PG8_BAR; PG8_WAIT_L(0); PG8_MMA(1, 0, At, B0); PG8_BAR; PG8_SCHED;
            PG8_STAGE(PG8_SB(1, 1), b3 + hstep, voffB);
            PG8_WAIT_V(6); PG8_BAR; PG8_MMA(1, 1, At, B1); PG8_BAR;
            }
        }
        if constexpr (ALIGN_EPI) { if (wr == 0) PG8_BAR; }
        if constexpr (!Epi::AFTER_DRAIN) { E(acc, cur, wr, wc, fr, fq); S.done(cur); }
        if (!has_next) break;
#pragma unroll
        for (int a = 0; a < 2; ++a)
#pragma unroll
            for (int b = 0; b < 2; ++b)
#pragma unroll
                for (int m = 0; m < 4; ++m)
#pragma unroll
                    for (int n = 0; n < 2; ++n) acc[a][b][m][n] = (f32x4){0.f, 0.f, 0.f, 0.f};
        cur = nxt; cA = nA; cB = nB; ++ui;
        if constexpr (ALIGN_EPI) { if (wr == 1) PG8_BAR; }
    }
    PG8_WAIT_V(0);
    if constexpr (!ALIGN_EPI) { if (wr == 0) PG8_BAR; }
    PG8_BAR;
    if constexpr (Epi::AFTER_DRAIN) { E.fused(acc, cur, wr, wc, fr, fq, lds, wid, lane); S.done(cur); }
#undef PG8_SA
#undef PG8_SB
#undef PG8_STAGE
#undef PG8_LDA
#undef PG8_LDB
#undef PG8_MMA
#undef PG8_WAIT_V
#undef PG8_WAIT_L
#undef PG8_BAR
#undef PG8_SCHED
}
}
#define LAS __attribute__((address_space(3)))
typedef unsigned short bf16;
typedef short bf16x8 __attribute__((ext_vector_type(8)));
typedef float f32x4 __attribute__((ext_vector_type(4)));
typedef float f32x16 __attribute__((ext_vector_type(16)));
typedef unsigned v4u __attribute__((ext_vector_type(4)));
typedef unsigned v2u __attribute__((ext_vector_type(2)));

constexpr int T = 32768, S = 16384, D = 1024, FF = 2816, E2 = 2048, NWAVES = 8;
constexpr float RMS_EPS = 1e-6f, LN_EPS = 1e-5f;
constexpr float C2 = 0.125f * 1.4426950408889634f;
constexpr size_t MiB = 1u << 20;
constexpr size_t WS_CTL = 0;
constexpr size_t WS_WQKV = 2 * MiB, WS_WO = 8 * MiB, WS_WIN = 10 * MiB, WS_WOUT = 18 * MiB, WS_WUP = 22 * MiB  , WS_WDN = 44 * MiB  , WS_WSB = 55 * MiB;
constexpr size_t WS_XN = 56 * MiB, WS_MF = 120 * MiB;
constexpr size_t WS_QK = 248 * MiB, WS_VT = 376 * MiB, WS_O = 440 * MiB;
constexpr size_t WS_A1 = 120 * MiB, WS_G1 = 296 * MiB;
constexpr size_t WS_U = 120 * MiB, WS_VT2 = 248 * MiB, WS_Y = 376 * MiB;
constexpr size_t WS_END = 504 * MiB;
constexpr int CW_ATTQ = 64;
constexpr int LDS_BYTES = 147456;

__device__ __forceinline__ unsigned f2bf(float f) { unsigned u = __builtin_bit_cast(unsigned, f); return (u + 0x7fffu + ((u >> 16) & 1u)) >> 16; }
__device__ __forceinline__ unsigned pk2(float lo, float hi) { return f2bf(lo) | (f2bf(hi) << 16); }
__device__ __forceinline__ float bflo(unsigned w) { return __builtin_bit_cast(float, w << 16); }
__device__ __forceinline__ float bfhi(unsigned w) { return __builtin_bit_cast(float, w & 0xffff0000u); }
__device__ __forceinline__ float wave_sum(float v) {
#pragma unroll
    for (int o = 1; o < 64; o <<= 1) v += __shfl_xor(v, o);
    return v;
}
__device__ __forceinline__ int opaque_tid() { int t = threadIdx.x; asm volatile("" : "+v"(t)); return t; }
#define LDS_WAIT() asm volatile("s_waitcnt lgkmcnt(0)" ::: "memory")
#define VM_WAIT() asm volatile("s_waitcnt vmcnt(0)" ::: "memory")

__device__ __forceinline__ void p0_transpose_item(const float* W, int K, int N, bf16* WT, LAS float* scr, int item, int lane) {
    const int nblk = N / 32, kb = item / nblk, nb = item % nblk, k0 = 64 * kb, n0 = 32 * nb;
#pragma unroll 8
    for (int i = 0; i < 32; ++i) { const int kk = 2 * i + (lane >> 5); scr[kk * 33 + (lane & 31)] = W[(size_t)(k0 + kk) * N + n0 + (lane & 31)]; }
    LDS_WAIT(); asm volatile("" ::: "memory");
    const int c = lane & 7;
#pragma unroll
    for (int j = 0; j < 4; ++j) { const int n = (lane >> 3) + 8 * j; const LAS float* s = scr + (8 * c) * 33 + n;
        v4u o; o.x = pk2(s[0 * 33], s[1 * 33]); o.y = pk2(s[2 * 33], s[3 * 33]); o.z = pk2(s[4 * 33], s[5 * 33]); o.w = pk2(s[6 * 33], s[7 * 33]);
        *(v4u*)(WT + (size_t)(n0 + n) * K + k0 + 8 * c) = o; }
    LDS_WAIT(); asm volatile("" ::: "memory");
}
__device__ __forceinline__ void rms_row_to_bf16(const float* xrow, const float* gain, bf16* orow, int lane) {
    const f32x4* xr = (const f32x4*)xrow + lane; const f32x4* gr = (const f32x4*)gain + lane;
    f32x4 v[4]; float s = 0.f;
#pragma unroll
    for (int j = 0; j < 4; ++j) { v[j] = xr[64 * j]; s += (v[j].x * v[j].x + v[j].y * v[j].y) + (v[j].z * v[j].z + v[j].w * v[j].w); }
    const float r = 1.0f / sqrtf(wave_sum(s) * (1.f / D) + RMS_EPS);
    v2u* o8 = (v2u*)orow + lane;
#pragma unroll
    for (int j = 0; j < 4; ++j) { const f32x4 g = gr[64 * j]; v2u w; w.x = pk2(v[j].x * r * g.x, v[j].y * r * g.y); w.y = pk2(v[j].z * r * g.z, v[j].w * r * g.w); o8[64 * j] = w; }
}
__device__ __forceinline__ void rowwise_phase(const float* MF, const float* gpost, const float* xin, float* xout, const float* gpre, bf16* XN, int bid, int G) {
    const int tid = opaque_tid(), lane = tid & 63, gw = bid * NWAVES + (tid >> 6), NGW = G * NWAVES;
    for (int row = gw; row < T; row += NGW) {
        const f32x4* mr = (const f32x4*)(MF + (size_t)row * D) + lane; const f32x4* xr = (const f32x4*)(xin + (size_t)row * D) + lane;
        f32x4* xo = (f32x4*)(xout + (size_t)row * D) + lane;
        f32x4 v[4]; float s = 0.f;
#pragma unroll
        for (int j = 0; j < 4; ++j) { v[j] = mr[64 * j]; s += (v[j].x * v[j].x + v[j].y * v[j].y) + (v[j].z * v[j].z + v[j].w * v[j].w); }
        const float r1 = 1.0f / sqrtf(wave_sum(s) * (1.f / D) + RMS_EPS);
        float s2 = 0.f;
#pragma unroll
        for (int j = 0; j < 4; ++j) { const f32x4 g = ((const f32x4*)gpost + lane)[64 * j]; const f32x4 xv = xr[64 * j]; v[j] = xv + v[j] * r1 * g; xo[64 * j] = v[j];
            s2 += (v[j].x * v[j].x + v[j].y * v[j].y) + (v[j].z * v[j].z + v[j].w * v[j].w); }
        if (gpre) {
            const float r2 = 1.0f / sqrtf(wave_sum(s2) * (1.f / D) + RMS_EPS);
            v2u* o8 = (v2u*)(XN + (size_t)row * D) + lane;
#pragma unroll
            for (int j = 0; j < 4; ++j) { const f32x4 g = ((const f32x4*)gpre + lane)[64 * j]; v2u w; w.x = pk2(v[j].x * r2 * g.x, v[j].y * r2 * g.y); w.y = pk2(v[j].z * r2 * g.z, v[j].w * r2 * g.w); o8[64 * j] = w; }
        }
    }
}
__device__ __forceinline__ void act_phase(const bf16* A1, bf16* G1, const float* cw, const float* cb, int bid, int G) {
    const int gtid = bid * 512 + opaque_tid(), NT_ = G * 512;
    constexpr int NCH = FF / 8, NITEM = (T / 16) * NCH;
    for (int it = gtid; it < NITEM; it += NT_) {
        const int strip = it / NCH, ch = it % NCH, t0 = strip * 16, f0 = ch * 8;
        float w0[8], w1[8], w2[8], bb[8];
#pragma unroll
        for (int e = 0; e < 8; ++e) { w0[e] = cw[f0 + e]; w1[e] = cw[FF + f0 + e]; w2[e] = cw[2 * FF + f0 + e]; bb[e] = cb[f0 + e]; }
        v4u p2 = (v4u){0u, 0u, 0u, 0u}, p1 = p2;
        if ((t0 & (S - 1)) != 0) { p2 = *(const v4u*)(A1 + (size_t)(t0 - 2) * FF + f0); p1 = *(const v4u*)(A1 + (size_t)(t0 - 1) * FF + f0); }
#pragma unroll 4
        for (int i = 0; i < 16; ++i) {
            const v4u c = *(const v4u*)(A1 + (size_t)(t0 + i) * FF + f0); const v4u g = *(const v4u*)(G1 + (size_t)(t0 + i) * FF + f0);
            v4u o;
#pragma unroll
            for (int q = 0; q < 4; ++q) {
                const float a0 = bb[2 * q] + w0[2 * q] * bflo(p2[q]) + w1[2 * q] * bflo(p1[q]) + w2[2 * q] * bflo(c[q]);
                const float a1 = bb[2 * q + 1] + w0[2 * q + 1] * bfhi(p2[q]) + w1[2 * q + 1] * bfhi(p1[q]) + w2[2 * q + 1] * bfhi(c[q]);
                o[q] = pk2(pg8::gelu_tanh(a0) * bflo(g[q]), pg8::gelu_tanh(a1) * bfhi(g[q]));
            }
            *(v4u*)(G1 + (size_t)(t0 + i) * FF + f0) = o;
            p2 = p1; p1 = c;
        }
    }
}

namespace att {
constexpr int STAGE = 32768;
__device__ __forceinline__ int crow(int r, int hi) { return (r & 3) + 8 * (r >> 2) + 4 * hi; }
__device__ __forceinline__ void dma_tile(LAS unsigned char* st, const bf16* QK, const bf16* VT, int b, int h, int t, int wid, int lane) {
#pragma unroll
    for (int i = 0; i < 4; ++i) {
        const int p = 4 * wid + i; const bf16* src; int dst;
        if (p < 16) { const int map = p >> 3, ch = p & 7; src = QK + (size_t)(b * S + 64 * t + lane) * 2048 + 1024 + h * 128 + map * 64 + ch * 8; dst = map * 8192 + ch * 1024; }
        else { const int q = p - 16, ch = q >> 1, vh = q & 1; src = VT + (size_t)(h * 128 + vh * 64 + lane) * T + (size_t)b * S + 64 * t + ch * 8; dst = 16384 + ch * 2048 + vh * 1024; }
        __builtin_amdgcn_global_load_lds((const unsigned*)src, (LAS unsigned*)(st + dst), 16, 0, 0);
    }
}
__device__ __forceinline__ bf16x8 pack8(const f32x16& p, int o) {
    v4u w; w.x = pg8::cvt_pk_bf16(p[o + 0], p[o + 1]); w.y = pg8::cvt_pk_bf16(p[o + 2], p[o + 3]); w.z = pg8::cvt_pk_bf16(p[o + 4], p[o + 5]); w.w = pg8::cvt_pk_bf16(p[o + 6], p[o + 7]);
    return __builtin_bit_cast(bf16x8, w);
}
__device__ __forceinline__ void attn_unit(LAS unsigned char* lds, const bf16* QK, const bf16* VT, bf16* O, int b, int h, int qb, float lam, const float* subln, int tid) {
    const int lane = tid & 63, r32 = lane & 31, hi = lane >> 5, wid = __builtin_amdgcn_readfirstlane(tid >> 6);
    const int map = wid >> 2, wq = wid & 3, q0 = qb * 128, qw = q0 + 32 * wq, qpos = qw + r32;
    const float sl2 = __builtin_amdgcn_exp2f(-(float)(h + 1)) * 1.4426950408889634f;
    const bf16* qp = QK + (size_t)(b * S + qpos) * 2048 + h * 128 + map * 64 + hi * 8;
    bf16x8 qr[4];
#pragma unroll
    for (int d0 = 0; d0 < 4; ++d0) qr[d0] = *(const bf16x8*)(qp + 16 * d0);
    f32x16 o[4];
#pragma unroll
    for (int d0 = 0; d0 < 4; ++d0)
#pragma unroll
        for (int r = 0; r < 16; ++r) o[d0][r] = 0.f;
    float m_run = -1e30f, l = 0.f;
    const int NT = (q0 + 128) / 64;
    const int pk = (r32 & ~12) | ((r32 & 4) << 1) | ((r32 & 8) >> 1);
    const int koff = map * 8192 + hi * 1024 + pk * 16, voff = 16384 + hi * 2048 + r32 * 16;
    int buf = 0;
    dma_tile(lds, QK, VT, b, h, NT - 1, wid, lane);
    VM_WAIT(); __syncthreads();
    for (int t = NT - 1; t >= 0; --t) {
        if (t > 0) dma_tile(lds + (buf ^ 1) * STAGE, QK, VT, b, h, t - 1, wid, lane);
        if (64 * t <= qw + 31) {
            const LAS unsigned char* st = lds + buf * STAGE;
            f32x16 p0, p1;
#pragma unroll
            for (int r = 0; r < 16; ++r) { p0[r] = 0.f; p1[r] = 0.f; }
#pragma unroll
            for (int d0 = 0; d0 < 4; ++d0) {
                const bf16x8 k0 = *(const LAS bf16x8*)(st + koff + d0 * 2048), k1 = *(const LAS bf16x8*)(st + koff + d0 * 2048 + 512);
                p0 = __builtin_amdgcn_mfma_f32_32x32x16_bf16(k0, qr[d0], p0, 0, 0, 0); p1 = __builtin_amdgcn_mfma_f32_32x32x16_bf16(k1, qr[d0], p1, 0, 0, 0);
            }
            const int relb = 64 * t + 8 * hi - qpos;
            const float fb = sl2 * (float)relb;
#pragma unroll
            for (int r = 0; r < 16; ++r) { const int c = 16 * (r >> 3) + (r & 7); p0[r] += fb + sl2 * (float)c; p1[r] += fb + sl2 * (float)(c + 32); }
            if (64 * t + 63 > qw) {
#pragma unroll
                for (int r = 0; r < 16; ++r) { const int c = 16 * (r >> 3) + (r & 7); if (relb + c > 0) p0[r] = -1e30f; if (relb + c + 32 > 0) p1[r] = -1e30f; }
            }
            float mx = fmaxf(p0[0], p1[0]);
#pragma unroll
            for (int r = 1; r < 16; ++r) mx = fmaxf(mx, fmaxf(p0[r], p1[r]));
            mx = fmaxf(mx, __shfl_xor(mx, 32));
            const float m_new = fmaxf(m_run, mx), alpha = __builtin_amdgcn_exp2f(m_run - m_new); m_run = m_new;
            float ps = 0.f;
#pragma unroll
            for (int r = 0; r < 16; ++r) { p0[r] = __builtin_amdgcn_exp2f(p0[r] - m_new); p1[r] = __builtin_amdgcn_exp2f(p1[r] - m_new); ps += p0[r] + p1[r]; }
            l = l * alpha + ps;
#pragma unroll
            for (int d0 = 0; d0 < 4; ++d0)
#pragma unroll
                for (int r = 0; r < 16; ++r) o[d0][r] *= alpha;
            bf16x8 pf[4]; pf[0] = pack8(p0, 0); pf[1] = pack8(p0, 8); pf[2] = pack8(p1, 0); pf[3] = pack8(p1, 8);
#pragma unroll
            for (int d0 = 0; d0 < 4; ++d0)
#pragma unroll
                for (int s = 0; s < 4; ++s) { const bf16x8 vf = *(const LAS bf16x8*)(st + voff + s * 4096 + d0 * 512); o[d0] = __builtin_amdgcn_mfma_f32_32x32x16_bf16(vf, pf[s], o[d0], 0, 0, 0); }
        }
        VM_WAIT(); LDS_WAIT(); __syncthreads(); buf ^= 1;
    }
    l += __shfl_xor(l, 32);
    const float inv = 1.0f / l;
    LAS float* X = (LAS float*)lds;
    if (map == 1) {
#pragma unroll
        for (int d0 = 0; d0 < 4; ++d0)
#pragma unroll
            for (int r = 0; r < 16; ++r) X[(wq * 128 + 32 * d0 + crow(r, hi)) * 32 + r32] = o[d0][r] * inv;
    }
    LDS_WAIT(); __syncthreads();
    if (map == 0) {
        float ss = 0.f;
#pragma unroll
        for (int d0 = 0; d0 < 4; ++d0)
#pragma unroll
            for (int r = 0; r < 16; ++r) { const float v = o[d0][r] * inv - lam * X[(wq * 128 + 32 * d0 + crow(r, hi)) * 32 + r32]; o[d0][r] = v; ss += v * v; }
        ss += __shfl_xor(ss, 32);
        const float rs = 0.8f / sqrtf(ss * (1.f / 128.f) + RMS_EPS);
        bf16* op = O + (size_t)(b * S + qpos) * D + h * 128 + 4 * hi;
#pragma unroll
        for (int d0 = 0; d0 < 4; ++d0)
#pragma unroll
            for (int r4 = 0; r4 < 4; ++r4) { const int vd0 = 32 * d0 + 8 * r4; const f32x4 g = *(const f32x4*)(subln + vd0 + 4 * hi);
                v2u w; w.x = pk2(o[d0][4 * r4] * rs * g.x, o[d0][4 * r4 + 1] * rs * g.y); w.y = pk2(o[d0][4 * r4 + 2] * rs * g.z, o[d0][4 * r4 + 3] * rs * g.w);
                *(v2u*)(op + vd0) = w; }
    }
}
__device__ __forceinline__ void attn_phase(LAS unsigned char* lds, const bf16* QK, const bf16* VT, bf16* O, const float* lq1, const float* lk1, const float* lq2, const float* lk2,
                                           const float* subln, unsigned* qctr, int tid) {
    const int lane = tid & 63;
    const float d1 = wave_sum(lq1[lane] * lk1[lane]), d2 = wave_sum(lq2[lane] * lk2[lane]);
    const float lam = expf(d1) - expf(d2) + 0.2f;
    LAS unsigned* su = (LAS unsigned*)(lds + 2 * STAGE);
    for (;;) {
        if (tid == 0) su[0] = atomicAdd(qctr, 1u);
        LDS_WAIT(); __syncthreads();
        const unsigned u = su[0];
        if (u >= 2048u) break;
        const int qb = 127 - (int)(u >> 4), bh = (int)(u & 15);
        attn_unit(lds, QK, VT, O, bh >> 3, bh & 7, qb, lam, subln, tid);
    }
}
}

__device__ __forceinline__ void sgu_phase(LAS unsigned char* lds, bf16* VT2, const bf16* U, bf16* Y, const bf16* Wsb, const float* ln_g, const float* ln_b, const float* b_s, int tid, int bid, int nblk) {
    const int lane = tid & 63, r32 = lane & 31, hi = lane >> 5, wid = __builtin_amdgcn_readfirstlane(tid >> 6);
    LAS float* sS = (LAS float*)lds;
    LAS float* sMu = (LAS float*)(lds + 8192); LAS float* sRs = sMu + 128;
    for (int chunk = bid; chunk < T / 128; chunk += nblk) {
        const int tok0 = chunk * 128, tg = tid & 15, cp = tid >> 4;
        bf16* vp = VT2 + (size_t)(cp * 64) * T + tok0 + 8 * tg;
        float sm[8], sq[8];
#pragma unroll
        for (int j = 0; j < 8; ++j) { sm[j] = 0.f; sq[j] = 0.f; }
#pragma unroll 4
        for (int i = 0; i < 64; ++i) { const v4u v = *(const v4u*)(vp + (size_t)i * T);
#pragma unroll
            for (int q = 0; q < 4; ++q) { const float a = bflo(v[q]), c = bfhi(v[q]); sm[2 * q] += a; sq[2 * q] += a * a; sm[2 * q + 1] += c; sq[2 * q + 1] += c * c; } }
#pragma unroll
        for (int j = 0; j < 8; ++j) { sm[j] += __shfl_xor(sm[j], 16); sm[j] += __shfl_xor(sm[j], 32); sq[j] += __shfl_xor(sq[j], 16); sq[j] += __shfl_xor(sq[j], 32); }
        if (lane < 16) {
#pragma unroll
            for (int j = 0; j < 8; ++j) { sS[(wid * 128 + 8 * tg + j) * 2] = sm[j]; sS[(wid * 128 + 8 * tg + j) * 2 + 1] = sq[j]; } }
        LDS_WAIT(); __syncthreads();
        if (tid < 128) { float s = 0.f, q = 0.f;
#pragma unroll
            for (int w = 0; w < 8; ++w) { s += sS[(w * 128 + tid) * 2]; q += sS[(w * 128 + tid) * 2 + 1]; }
            const float mu = s * (1.f / E2), var = fmaxf(q * (1.f / E2) - mu * mu, 0.f); sMu[tid] = mu; sRs[tid] = 1.0f / sqrtf(var + LN_EPS); }
        LDS_WAIT(); __syncthreads();
        float mu[8], rs[8];
#pragma unroll
        for (int j = 0; j < 8; ++j) { mu[j] = sMu[8 * tg + j]; rs[j] = sRs[8 * tg + j]; }
#pragma unroll 4
        for (int i = 0; i < 64; ++i) { const float g = ln_g[cp * 64 + i], be = ln_b[cp * 64 + i]; const v4u v = *(const v4u*)(vp + (size_t)i * T); v4u o;
#pragma unroll
            for (int q = 0; q < 4; ++q) o[q] = pk2((bflo(v[q]) - mu[2 * q]) * rs[2 * q] * g + be, (bfhi(v[q]) - mu[2 * q + 1]) * rs[2 * q + 1] * g + be);
            *(v4u*)(vp + (size_t)i * T) = o; }
        VM_WAIT(); __syncthreads();
        const int g = wid;
#pragma unroll 1
        for (int cb = 0; cb < 8; ++cb) {
            f32x16 acc[4];
#pragma unroll
            for (int nb = 0; nb < 4; ++nb)
#pragma unroll
                for (int r = 0; r < 16; ++r) acc[nb][r] = 0.f;
            const bf16* ap = VT2 + (size_t)(g * 256 + cb * 32 + r32) * T + tok0 + 8 * hi;
            const bf16* wp = Wsb + ((size_t)g * 128 + r32) * 128 + 8 * hi;
#pragma unroll
            for (int ks = 0; ks < 8; ++ks) {
                const bf16x8 a = *(const bf16x8*)(ap + 16 * ks);
#pragma unroll
                for (int nb = 0; nb < 4; ++nb) if (nb >= (ks >> 1)) { const bf16x8 w = *(const bf16x8*)(wp + (size_t)(32 * nb) * 128 + 16 * ks); acc[nb] = __builtin_amdgcn_mfma_f32_32x32x16_bf16(a, w, acc[nb], 0, 0, 0); }
            }
#pragma unroll
            for (int nb = 0; nb < 4; ++nb) { const int t = 32 * nb + r32; const float bs = b_s[g * 128 + t];
                const size_t ro = (size_t)(tok0 + t) * E2 + g * 256 + cb * 32 + 4 * hi;
#pragma unroll
                for (int r4 = 0; r4 < 4; ++r4) { const v2u uu = *(const v2u*)(U + ro + 8 * r4); v2u w;
                    w.x = pk2(bflo(uu.x) * (acc[nb][4 * r4] + bs), bfhi(uu.x) * (acc[nb][4 * r4 + 1] + bs)); w.y = pk2(bflo(uu.y) * (acc[nb][4 * r4 + 2] + bs), bfhi(uu.y) * (acc[nb][4 * r4 + 3] + bs));
                    *(v2u*)(Y + ro + 8 * r4) = w; } }
        }
        __syncthreads();
    }
}

struct Args { const float* in[22]; float* out; unsigned char* ws; };

#define GEMM(EPI, Aptr, Bptr, M_, N_, K_, ...) do { pg8::Gemm g_{(const pg8::bf16_t*)(Aptr), (const pg8::bf16_t*)(Bptr), (M_), (N_), (K_)}; pg8::StaticOrder S_; S_.init((M_), (N_), G, bid); \
    EPI E_{__VA_ARGS__}; pg8::gemm_phase<EPI, pg8::StaticOrder, true, true>(lds, g_, S_, E_); } while (0)

__global__ void __launch_bounds__(512) mega_fwd(Args a) {
    extern __shared__ __attribute__((aligned(16))) unsigned char lds_raw[];
    LAS unsigned char* lds = (LAS unsigned char*)lds_raw;
    cg::grid_group grid = cg::this_grid();
    const int tid = threadIdx.x, lane = tid & 63, wid = __builtin_amdgcn_readfirstlane(tid >> 6), bid = blockIdx.x, G = gridDim.x;
    const int gw = bid * NWAVES + wid, NGW = G * NWAVES, gtid = bid * 512 + tid, NTHR = G * 512;
    unsigned char* ws = a.ws;
    bf16 *Wqkv = (bf16*)(ws + WS_WQKV), *Wo = (bf16*)(ws + WS_WO), *Win = (bf16*)(ws + WS_WIN), *Wout = (bf16*)(ws + WS_WOUT), *Wup = (bf16*)(ws + WS_WUP), *Wdn = (bf16*)(ws + WS_WDN), *Wsb = (bf16*)(ws + WS_WSB);
    bf16 *XN = (bf16*)(ws + WS_XN), *QK = (bf16*)(ws + WS_QK), *VT = (bf16*)(ws + WS_VT), *Ob = (bf16*)(ws + WS_O), *A1 = (bf16*)(ws + WS_A1), *G1 = (bf16*)(ws + WS_G1);
    bf16 *U = (bf16*)(ws + WS_U), *VT2 = (bf16*)(ws + WS_VT2), *Y = (bf16*)(ws + WS_Y);
    float* MF = (float*)(ws + WS_MF); float* out = a.out;
    const float* x = a.in[0];

    {
        LAS float* scr = (LAS float*)(lds + wid * 16384);
        constexpr int I0 = 16 * 96, I1 = 16 * 32, I2 = 16 * 128, I3 = 32 * 32, I4 = 16 * 176, I5 = 44 * 32;
        constexpr int NIT = I0 + I1 + I2 + I3 + 2 * I4 + 2 * I5;
        for (int it = gw; it < NIT; it += NGW) {
            int r = it;
            if (r < I0) { p0_transpose_item(a.in[1], D, 3 * D, Wqkv, scr, r, lane); continue; } r -= I0;
            if (r < I1) { p0_transpose_item(a.in[7], D, D, Wo, scr, r, lane); continue; } r -= I1;
            if (r < I2) { p0_transpose_item(a.in[8], D, 2 * E2, Win, scr, r, lane); continue; } r -= I2;
            if (r < I3) { p0_transpose_item(a.in[13], E2, D, Wout, scr, r, lane); continue; } r -= I3;
            if (r < I4) { p0_transpose_item(a.in[18], D, 2 * FF, Wup, scr, r, lane); continue; } r -= I4;
            if (r < I4) { p0_transpose_item(a.in[18] + (size_t)D * 2 * FF, D, 2 * FF, Wup + (size_t)2 * FF * D, scr, r, lane); continue; } r -= I4;
            if (r < I5) { p0_transpose_item(a.in[21], FF, D, Wdn, scr, r, lane); continue; } r -= I5;
            p0_transpose_item(a.in[21] + (size_t)FF * D, FF, D, Wdn + (size_t)D * FF, scr, r, lane);
        }
        for (int i = gtid; i < 8 * 128 * 128; i += NTHR) { const int s = i & 127, t = (i >> 7) & 127; Wsb[i] = (bf16)(s <= t ? f2bf(a.in[11][i]) : 0u); }
        for (int m = gw; m < T; m += NGW) rms_row_to_bf16(x + (size_t)m * D, a.in[14], XN + (size_t)m * D, lane);
    }
    __syncthreads(); grid.sync();
    GEMM(pg8::EpiB<0>, XN, Wqkv, T, 2 * D, D, QK, 2 * D, 0, 0, D, C2);
    GEMM(pg8::EpiB<0>, Wqkv + (size_t)2 * D * D, XN, D, T, D, VT, T, 0, 0, 0, 1.f);
    grid.sync();
    att::attn_phase(lds, QK, VT, Ob, a.in[2], a.in[3], a.in[4], a.in[5], a.in[6], (unsigned*)(ws + WS_CTL) + CW_ATTQ, opaque_tid());
    __syncthreads(); grid.sync();
    GEMM(pg8::EpiF, Ob, Wo, T, D, D, MF, D);
    grid.sync();
    rowwise_phase(MF, a.in[15], x, out, a.in[16], XN, bid, G);
    grid.sync();
#pragma unroll 1
    for (int L = 0; L < 2; ++L) {
        GEMM(pg8::EpiB<0>, XN, Wup + (size_t)L * 2 * FF * D, T, 2 * FF, D, A1, FF, FF, (size_t)(WS_G1 - WS_A1) / 2, 0, 1.f);
        grid.sync();
        act_phase(A1, G1, a.in[19] + (size_t)L * 3 * FF, a.in[20] + (size_t)L * FF, bid, G);
        grid.sync();
        GEMM(pg8::EpiF, G1, Wdn + (size_t)L * D * FF, T, D, FF, MF, D);
        grid.sync();
        if (L == 0) rowwise_phase(MF, a.in[17], out, out, a.in[14] + D, XN, bid, G);
        else        rowwise_phase(MF, a.in[17] + D, out, out, nullptr, XN, bid, G);
        if (L == 1) break;
        grid.sync();
        GEMM(pg8::EpiB<1>, XN, Win, T, E2, D, U, E2, 0, 0, 0, 1.f);
        GEMM(pg8::EpiB<1>, Win + (size_t)E2 * D, XN, E2, T, D, VT2, T, 0, 0, 0, 1.f);
        grid.sync();
        sgu_phase(lds, VT2, U, Y, Wsb, a.in[9], a.in[10], a.in[12], opaque_tid(), bid, G);
        grid.sync();
        GEMM(pg8::EpiF, Y, Wout, T, D, E2, MF, D);
        grid.sync();
        rowwise_phase(MF, a.in[15] + D, out, out, a.in[16] + D, XN, bid, G);
        grid.sync();
    }
}

extern "C" void kernel_launch(void* const* d_in, const int* in_sizes, int n_in, void* d_out, int out_size, void* d_ws, size_t ws_size, hipStream_t stream) {
    static int grid = 0;
    if (grid == 0) {
        if (n_in != 22 || out_size != T * D || ws_size < WS_END) { fprintf(stderr, "kernel_launch: unexpected shapes (n_in %d out %d ws %zu)\n", n_in, out_size, ws_size); grid = -1; return; }
        int dev = 0, cus = 0, per_cu = 0;
        hipGetDevice(&dev); hipDeviceGetAttribute(&cus, hipDeviceAttributeMultiprocessorCount, dev);
        hipFuncSetAttribute((const void*)mega_fwd, hipFuncAttributeMaxDynamicSharedMemorySize, LDS_BYTES);
        if (hipOccupancyMaxActiveBlocksPerMultiprocessor(&per_cu, (const void*)mega_fwd, 512, LDS_BYTES) != hipSuccess || per_cu < 1) per_cu = 1;
        (void)hipGetLastError();
        grid = cus * per_cu;
    }
    if (grid < 0) return;
    hipMemsetAsync((char*)d_ws + WS_CTL, 0, 4096, stream);
    Args a{};
    for (int i = 0; i < 22; ++i) a.in[i] = (const float*)d_in[i];
    a.out = (float*)d_out; a.ws = (unsigned char*)d_ws;
    void* args[] = {&a};
    hipError_t e = hipLaunchCooperativeKernel((const void*)mega_fwd, dim3(grid), dim3(512), args, LDS_BYTES, stream);
    if (e != hipSuccess) fprintf(stderr, "cooperative launch failed: %s (grid %d)\n", hipGetErrorString(e), grid);
}
```

```cpp
#include <hip/hip_runtime.h>
#include <hip/hip_cooperative_groups.h>
#include <cstdio>
#include <cstdint>
namespace cg = cooperative_groups;
namespace pg8 {
#define PG8_LAS __attribute__((address_space(3)))
typedef unsigned short bf16_t;
typedef short bf16x8 __attribute__((ext_vector_type(8)));
typedef float f32x4 __attribute__((ext_vector_type(4)));
typedef unsigned u32x4 __attribute__((ext_vector_type(4)));
constexpr int BM = 256, BK = 64, HALF = 128, HTB = HALF * BK * 2  , STAGE_BYTES = 8 * HTB, NXCD = 8, WGM = 8;

__host__ __device__ __forceinline__ int lds_byte(int r, int c) { const int st = (r >> 4) * 2 + (c >> 5), rr = r & 15, cc = c & 31, ob = rr * 64 + cc * 2; return st * 1024 + (ob ^ (((ob >> 9) & 1) << 5)); }
__host__ __device__ __forceinline__ void stage_rc(int b, int& R, int& C) { const int st = b / 1024, sb = b % 1024, swz = sb ^ (((sb >> 9) & 1) << 5); R = (st >> 1) * 16 + swz / 64; C = (st & 1) * 32 + (swz % 64) / 2; }
__host__ __device__ __forceinline__ int perm32(int rho) { const int n = rho >> 4, i = rho & 15; return 8 * (i >> 2) + 4 * n + (i & 3); }

struct Unit { int pm, pn; };
struct Gemm { const bf16_t* A; const bf16_t* Bt; int M, N, K; };

struct StaticOrder {
    int nM, nN, nwg, G, c;
    __host__ __device__ void init(int M, int N, int G_, int c_) { nM = M / BM; nN = N / BM; nwg = nM * nN; G = G_; c = c_; }
    __host__ __device__ bool next(int i, Unit& u) const {
        const long L = (long)i * G + c; if (L >= nwg) return false;
        int wgid = (int)L; { const int q = nwg / NXCD, r = nwg % NXCD, xcd = wgid % NXCD, off = wgid / NXCD; wgid = (xcd < r ? xcd * (q + 1) : r * (q + 1) + (xcd - r) * q) + off; }
        const int nig = WGM * nN, gid = wgid / nig, fm = gid * WGM, gsz = (nM - fm) < WGM ? (nM - fm) : WGM;
        u.pm = fm + ((wgid % nig) % gsz); u.pn = (wgid % nig) / gsz; return true;
    }
    __device__ __forceinline__ void a_ready(const Unit&) const {}
    __device__ __forceinline__ void done(const Unit&) const {}
};

__device__ __forceinline__ unsigned cvt_pk_bf16(float lo, float hi) { unsigned r; asm volatile("v_cvt_pk_bf16_f32 %0, %1, %2" : "=v"(r) : "v"(lo), "v"(hi)); return r; }
typedef float f32x2 __attribute__((ext_vector_type(2)));
__device__ __forceinline__ float gelu_tanh(float x) {
    const float e = __builtin_amdgcn_exp2f(-2.302208198f * x * (1.0f + 0.044715f * x * x));
    return x * __builtin_amdgcn_rcpf(1.0f + e);
}
template <int ACT> struct EpiB {
    static constexpr bool PERM = true, AFTER_DRAIN = false;
    bf16_t* O; int ldc; int split_cols; size_t split_stride; int scale_cols; float scale;
    __device__ __forceinline__ void operator()(const f32x4 (&acc)[2][2][4][2], const Unit& u, int wr, int wc, int fr, int fq) const {
        const int row0 = u.pm * BM + wr * 64 + fr; int colt = u.pn * BM; bf16_t* base = O;
        const float sc = (colt < scale_cols) ? scale : 1.f;
        if (split_cols) { const int t = colt / split_cols; base += (size_t)t * split_stride; colt -= t * split_cols; }
        const int col0 = colt + wc * 32 + 8 * fq;
#pragma unroll
        for (int ai = 0; ai < 2; ++ai)
#pragma unroll
            for (int m = 0; m < 4; ++m) { bf16_t* rowp = base + (size_t)(row0 + ai * HALF + m * 16) * ldc + col0;
#pragma unroll
                for (int bj = 0; bj < 2; ++bj) { f32x4 v0 = acc[ai][bj][m][0], v1 = acc[ai][bj][m][1];
                    if (ACT == 1) {
#pragma unroll
                        for (int e = 0; e < 4; ++e) { v0[e] = gelu_tanh(v0[e]); v1[e] = gelu_tanh(v1[e]); } }
                    v0 = v0 * sc; v1 = v1 * sc; u32x4 w; w.x = cvt_pk_bf16(v0[0], v0[1]); w.y = cvt_pk_bf16(v0[2], v0[3]); w.z = cvt_pk_bf16(v1[0], v1[1]); w.w = cvt_pk_bf16(v1[2], v1[3]);
                    *(u32x4*)(rowp + bj * HALF) = w; } }
    }
};

struct EpiQK {
    static constexpr bool PERM = true, AFTER_DRAIN = false;
    bf16_t* O; int ldc; int scale_cols; float scale; unsigned* nrm; int rows_per_batch;
    __device__ __forceinline__ void operator()(const f32x4 (&acc)[2][2][4][2], const Unit& u, int wr, int wc, int fr, int fq) const {
        const int row0 = u.pm * BM + wr * 64 + fr; const int colt = u.pn * BM;
        const float sc = (colt < scale_cols) ? scale : 1.f;
        const int col0 = colt + wc * 32 + 8 * fq;
        float mx0 = 0.f, mx1 = 0.f;
#pragma unroll
        for (int ai = 0; ai < 2; ++ai)
#pragma unroll
            for (int m = 0; m < 4; ++m) { bf16_t* rowp = O + (size_t)(row0 + ai * HALF + m * 16) * ldc + col0;
#pragma unroll
                for (int bj = 0; bj < 2; ++bj) { f32x4 v0 = acc[ai][bj][m][0] * sc, v1 = acc[ai][bj][m][1] * sc;
                    float ss = (v0[0] * v0[0] + v0[1] * v0[1]) + (v0[2] * v0[2] + v0[3] * v0[3]) + (v1[0] * v1[0] + v1[1] * v1[1]) + (v1[2] * v1[2] + v1[3] * v1[3]);
                    ss += __shfl_xor(ss, 16); ss += __shfl_xor(ss, 32);
                    if (bj == 0) mx0 = fmaxf(mx0, ss); else mx1 = fmaxf(mx1, ss);
                    u32x4 w; w.x = cvt_pk_bf16(v0[0], v0[1]); w.y = cvt_pk_bf16(v0[2], v0[3]); w.z = cvt_pk_bf16(v1[0], v1[1]); w.w = cvt_pk_bf16(v1[2], v1[3]);
                    *(u32x4*)(rowp + bj * HALF) = w; } }
#pragma unroll
        for (int o = 1; o < 16; o <<= 1) { mx0 = fmaxf(mx0, __shfl_xor(mx0, o)); mx1 = fmaxf(mx1, __shfl_xor(mx1, o)); }
        if (fr == 0 && fq == 0) { const int bb = (u.pm * BM) / rows_per_batch; const int cg0 = (colt + wc * 32) >> 5;
            atomicMax(nrm + bb * 64 + cg0, __builtin_bit_cast(unsigned, mx0)); atomicMax(nrm + bb * 64 + cg0 + 4, __builtin_bit_cast(unsigned, mx1)); }
    }
};
struct EpiF {
    static constexpr bool PERM = true, AFTER_DRAIN = false;
    float* O; int ldc;
    __device__ __forceinline__ void operator()(const f32x4 (&acc)[2][2][4][2], const Unit& u, int wr, int wc, int fr, int fq) const {
        const int row0 = u.pm * BM + wr * 64 + fr; const int col0 = u.pn * BM + wc * 32 + 8 * fq;
#pragma unroll
        for (int ai = 0; ai < 2; ++ai)
#pragma unroll
            for (int m = 0; m < 4; ++m) { float* rowp = O + (size_t)(row0 + ai * HALF + m * 16) * ldc + col0;
#pragma unroll
                for (int bj = 0; bj < 2; ++bj) { *(f32x4*)(rowp + bj * HALF) = acc[ai][bj][m][0]; *(f32x4*)(rowp + bj * HALF + 4) = acc[ai][bj][m][1]; } }
    }
};
template <class Epi, class Sched, bool ALIGN_EPI = false, bool SP2 = false>
__device__ __forceinline__ void gemm_phase(PG8_LAS unsigned char* lds, const Gemm g, const Sched& S, const Epi& E) {
    int tid_o = threadIdx.x; asm volatile("" : "+v"(tid_o));
    const int tid = tid_o, wid = __builtin_amdgcn_readfirstlane(tid >> 6), lane = tid & 63, wr = wid >> 2, wc = wid & 3, fr = lane & 15, fq = lane >> 4;
    const int K = g.K, nt = K / BK;
    unsigned voffA[2], voffB[2];
#pragma unroll
    for (int i = 0; i < 2; ++i) { int R, C; stage_rc(tid * 16 + i * 8192, R, C); const int Rb = Epi::PERM ? ((R & ~31) + perm32(R & 31)) : R;
        voffA[i] = (unsigned)(R * K + C) * 2u; voffB[i] = (unsigned)(Rb * K + C) * 2u; }
    const size_t kstep = (size_t)(BK * 2);
    const size_t hstep = (size_t)HALF * K * 2;
    const size_t tstep = 2 * hstep;
    const unsigned ldsw = (unsigned)wid * 1024u;
    const int aoff = lds_byte(wr * 64 + fr, fq * 8), boff = lds_byte(wc * 32 + fr, fq * 8);
#define PG8_SA(b, h) (((b) * 2 + (h)) * HTB)
#define PG8_SB(b, h) ((4 + (b) * 2 + (h)) * HTB)
#define PG8_STAGE(bufoff, gbase, voff) do { _Pragma("unroll") for (int _i = 0; _i < 2; ++_i) \
        __builtin_amdgcn_global_load_lds((const unsigned*)((const char*)(gbase) + (voff)[_i]), (PG8_LAS unsigned*)(lds + (bufoff) + ldsw + _i * 8192), 16, 0, 0); } while (0)
#define PG8_LDA(dst, b, h) do { _Pragma("unroll") for (int m = 0; m < 4; ++m) _Pragma("unroll") for (int k = 0; k < 2; ++k) dst[m][k] = *(const PG8_LAS bf16x8*)(lds + PG8_SA(b, h) + aoff + m * 2048 + k * 1024); } while (0)
#define PG8_LDB(dst, b, h) do { _Pragma("unroll") for (int n = 0; n < 2; ++n) _Pragma("unroll") for (int k = 0; k < 2; ++k) dst[n][k] = *(const PG8_LAS bf16x8*)(lds + PG8_SB(b, h) + boff + n * 2048 + k * 1024); } while (0)
#define PG8_MMA(ai, bj, At, Bt) do { __builtin_amdgcn_s_setprio(1); _Pragma("unroll") for (int m = 0; m < 4; ++m) _Pragma("unroll") for (int n = 0; n < 2; ++n) _Pragma("unroll") for (int k = 0; k < 2; ++k) \
        acc[ai][bj][m][n] = __builtin_amdgcn_mfma_f32_16x16x32_bf16(Bt[n][k], At[m][k], acc[ai][bj][m][n], 0, 0, 0); __builtin_amdgcn_s_setprio(0); } while (0)
#define PG8_WAIT_V(n) asm volatile("s_waitcnt vmcnt(" #n ")" ::: "memory")
#define PG8_WAIT_L(n) asm volatile("s_waitcnt lgkmcnt(" #n ")" ::: "memory")
#define PG8_BAR __builtin_amdgcn_s_barrier()
#define PG8_SCHED __builtin_amdgcn_sched_barrier(0)
    Unit cur, nxt; int ui = 0;
    if (!S.next(0, cur)) return;
    f32x4 acc[2][2][4][2];
#pragma unroll
    for (int a = 0; a < 2; ++a)
#pragma unroll
        for (int b = 0; b < 2; ++b)
#pragma unroll
            for (int m = 0; m < 4; ++m)
#pragma unroll
                for (int n = 0; n < 2; ++n) acc[a][b][m][n] = (f32x4){0.f, 0.f, 0.f, 0.f};
    bf16x8 At[4][2], B0[2][2], B1[2][2];
    const char* cA = (const char*)g.A + (size_t)cur.pm * tstep; const char* cB = (const char*)g.Bt + (size_t)cur.pn * tstep;
    S.a_ready(cur);
    if constexpr (SP2) {
        PG8_STAGE(PG8_SB(0, 0), cB, voffB); PG8_STAGE(PG8_SB(0, 1), cB + hstep, voffB); PG8_STAGE(PG8_SA(0, 0), cA, voffA); PG8_STAGE(PG8_SA(0, 1), cA + hstep, voffA);
        if (wr == 1) PG8_BAR;
        PG8_WAIT_V(2); PG8_BAR;
        PG8_STAGE(PG8_SB(1, 0), cB + kstep, voffB); PG8_STAGE(PG8_SA(1, 0), cA + kstep, voffA); PG8_STAGE(PG8_SB(1, 1), cB + hstep + kstep, voffB);
        PG8_WAIT_V(6); PG8_BAR;
    } else {
        PG8_STAGE(PG8_SB(0, 0), cB, voffB); PG8_STAGE(PG8_SA(0, 0), cA, voffA); PG8_STAGE(PG8_SB(0, 1), cB + hstep, voffB); PG8_STAGE(PG8_SA(0, 1), cA + hstep, voffA);
        if (wr == 1) PG8_BAR;
        PG8_WAIT_V(4); PG8_BAR;
        PG8_STAGE(PG8_SB(1, 0), cB + kstep, voffB); PG8_STAGE(PG8_SA(1, 0), cA + kstep, voffA); PG8_STAGE(PG8_SB(1, 1), cB + hstep + kstep, voffB);
        PG8_WAIT_V(6); PG8_BAR;
    }
    for (;;) {
        const bool has_next = S.next(ui + 1, nxt);
        const char* nA = has_next ? (const char*)g.A + (size_t)nxt.pm * tstep : cA; const char* nB = has_next ? (const char*)g.Bt + (size_t)nxt.pn * tstep : cB;
        for (int t = 0; t < nt; t += 2) {
            const bool last = (t == nt - 2);
            const char* a1 = cA + (size_t)(t + 1) * kstep;
            const char* a2 = last ? nA : cA + (size_t)(t + 2) * kstep; const char* b2 = last ? nB : cB + (size_t)(t + 2) * kstep;
            const char* a3 = a2 + kstep; const char* b3 = b2 + kstep;
            if (last && has_next) S.a_ready(nxt);
            if constexpr (SP2) {
            PG8_LDB(B0, 0, 0); PG8_LDB(B1, 0, 1); PG8_SCHED; PG8_LDA(At, 0, 0); PG8_STAGE(PG8_SA(1, 1), a1 + hstep, voffA);
            PG8_WAIT_V(8); PG8_WAIT_L(0); PG8_BAR; PG8_MMA(0, 0, At, B0); PG8_MMA(0, 1, At, B1); PG8_BAR; PG8_SCHED;
            PG8_LDA(At, 0, 1); PG8_STAGE(PG8_SB(0, 0), b2, voffB); PG8_STAGE(PG8_SB(0, 1), b2 + hstep, voffB); PG8_STAGE(PG8_SA(0, 0), a2, voffA);
            PG8_WAIT_V(8); PG8_WAIT_L(0); PG8_BAR; PG8_MMA(1, 0, At, B0); PG8_MMA(1, 1, At, B1); PG8_BAR; PG8_SCHED;
            PG8_LDB(B0, 1, 0); PG8_LDB(B1, 1, 1); PG8_SCHED; PG8_LDA(At, 1, 0); PG8_STAGE(PG8_SA(0, 1), a2 + hstep, voffA);
            PG8_WAIT_V(8); PG8_WAIT_L(0); PG8_BAR; PG8_MMA(0, 0, At, B0); PG8_MMA(0, 1, At, B1); PG8_BAR; PG8_SCHED;
            PG8_LDA(At, 1, 1); PG8_STAGE(PG8_SB(1, 0), b3, voffB); PG8_STAGE(PG8_SB(1, 1), b3 + hstep, voffB); PG8_STAGE(PG8_SA(1, 0), a3, voffA);
            PG8_WAIT_V(8); PG8_WAIT_L(0); PG8_BAR; PG8_MMA(1, 0, At, B0); PG8_MMA(1, 1, At, B1); PG8_BAR; PG8_SCHED;
            } else {
            PG8_LDB(B0, 0, 0); PG8_SCHED; PG8_LDA(At, 0, 0); PG8_STAGE(PG8_SA(1, 1), a1 + hstep, voffA);
            PG8_WAIT_L(8); PG8_BAR; PG8_WAIT_L(0); PG8_MMA(0, 0, At, B0); PG8_BAR; PG8_SCHED;
            PG8_LDB(B1, 0, 1); PG8_STAGE(PG8_SB(0, 0), b2, voffB);
            PG8_BAR; PG8_WAIT_L(0); PG8_MMA(0, 1, At, B1); PG8_BAR;
            PG8_LDA(At, 0, 1); PG8_STAGE(PG8_SA(0, 0), a2, voffA);
            PG8_BAR; PG8_WAIT_L(0); PG8_MMA(1, 0, At, B0); PG8_BAR; PG8_SCHED;
            PG8_STAGE(PG8_SB(0, 1), b2 + hstep, voffB);
            PG8_WAIT_V(6); PG8_BAR; PG8_MMA(1, 1, At, B1); PG8_BAR;
            PG8_LDB(B0, 1, 0); PG8_SCHED; PG8_LDA(At, 1, 0); PG8_STAGE(PG8_SA(0, 1), a2 + hstep, voffA);
            PG8_WAIT_L(8); PG8_BAR; PG8_WAIT_L(0); PG8_MMA(0, 0, At, B0); PG8_BAR; PG8_SCHED;
            PG8_LDB(B1, 1, 1); PG8_STAGE(PG8_SB(1, 0), b3, voffB);
            PG8_BAR; PG8_WAIT_L(0); PG8_MMA(0, 1, At, B1); PG8_BAR;
            PG8_LDA(At, 1, 1); PG8_STAGE(PG8_SA(1, 0), a3, voffA);
            PG8_BAR; PG8_WAIT_L(0); PG8_MMA(1, 0, At, B0); PG8_BAR; PG8_SCHED;
            PG8_STAGE(PG8_SB(1, 1), b3 + hstep, voffB);
            PG8_WAIT_V(6); PG8_BAR; PG8_MMA(1, 1, At, B1); PG8_BAR;
            }
        }
        if constexpr (ALIGN_EPI) { if (wr == 0) PG8_BAR; }
        if constexpr (!Epi::AFTER_DRAIN) { E(acc, cur, wr, wc, fr, fq); S.done(cur); }
        if (!has_next) break;
#pragma unroll
        for (int a = 0; a < 2; ++a)
#pragma unroll
            for (int b = 0; b < 2; ++b)
#pragma unroll
                for (int m = 0; m < 4; ++m)
#pragma unroll
                    for (int n = 0; n < 2; ++n) acc[a][b][m][n] = (f32x4){0.f, 0.f, 0.f, 0.f};
        cur = nxt; cA = nA; cB = nB; ++ui;
        if constexpr (ALIGN_EPI) { if (wr == 1) PG8_BAR; }
    }
    PG8_WAIT_V(0);
    if constexpr (!ALIGN_EPI) { if (wr == 0) PG8_BAR; }
    PG8_BAR;
    if constexpr (Epi::AFTER_DRAIN) { E.fused(acc, cur, wr, wc, fr, fq, lds, wid, lane); S.done(cur); }
#undef PG8_SA
#undef PG8_SB
#undef PG8_STAGE
#undef PG8_LDA
#undef PG8_LDB
#undef PG8_MMA
#undef PG8_WAIT_V
#undef PG8_WAIT_L
#undef PG8_BAR
#undef PG8_SCHED
}
}
#define LAS __attribute__((address_space(3)))
typedef unsigned short bf16;
typedef short bf16x8 __attribute__((ext_vector_type(8)));
typedef float f32x4 __attribute__((ext_vector_type(4)));
typedef float f32x16 __attribute__((ext_vector_type(16)));
typedef unsigned v4u __attribute__((ext_vector_type(4)));
typedef unsigned v2u __attribute__((ext_vector_type(2)));

constexpr int T = 32768, S = 16384, D = 1024, FF = 2816, E2 = 2048, NWAVES = 8;
constexpr float RMS_EPS = 1e-6f, LN_EPS = 1e-5f;
constexpr float C2 = 0.125f * 1.4426950408889634f;
constexpr size_t MiB = 1u << 20;
constexpr size_t WS_CTL = 0;
constexpr size_t WS_WQKV = 2 * MiB, WS_WO = 8 * MiB, WS_WIN = 10 * MiB, WS_WOUT = 18 * MiB, WS_WUP = 22 * MiB  , WS_WDN = 44 * MiB  , WS_WSB = 55 * MiB;
constexpr size_t WS_XN = 56 * MiB, WS_MF = 120 * MiB;
constexpr size_t WS_QK = 248 * MiB, WS_VT = 376 * MiB, WS_O = 440 * MiB;
constexpr size_t WS_A1 = 120 * MiB, WS_G1 = 296 * MiB;
constexpr size_t WS_U = 120 * MiB, WS_VT2 = 248 * MiB, WS_Y = 376 * MiB;
constexpr size_t WS_END = 504 * MiB;
constexpr int CW_ATTQ = 64, CW_NRM = 128;
constexpr int LDS_BYTES = 147456;

__device__ __forceinline__ unsigned f2bf(float f) { unsigned u = __builtin_bit_cast(unsigned, f); return (u + 0x7fffu + ((u >> 16) & 1u)) >> 16; }
__device__ __forceinline__ unsigned pk2(float lo, float hi) { return f2bf(lo) | (f2bf(hi) << 16); }
__device__ __forceinline__ float bflo(unsigned w) { return __builtin_bit_cast(float, w << 16); }
__device__ __forceinline__ float bfhi(unsigned w) { return __builtin_bit_cast(float, w & 0xffff0000u); }
__device__ __forceinline__ float wave_sum(float v) {
#pragma unroll
    for (int o = 1; o < 64; o <<= 1) v += __shfl_xor(v, o);
    return v;
}
__device__ __forceinline__ int opaque_tid() { int t = threadIdx.x; asm volatile("" : "+v"(t)); return t; }
#define LDS_WAIT() asm volatile("s_waitcnt lgkmcnt(0)" ::: "memory")
#define VM_WAIT() asm volatile("s_waitcnt vmcnt(0)" ::: "memory")

__device__ __forceinline__ void p0_transpose_item(const float* W, int K, int N, bf16* WT, LAS float* scr, int item, int lane) {
    const int nblk = N / 32, kb = item / nblk, nb = item % nblk, k0 = 64 * kb, n0 = 32 * nb;
#pragma unroll 8
    for (int i = 0; i < 32; ++i) { const int kk = 2 * i + (lane >> 5); scr[kk * 33 + (lane & 31)] = W[(size_t)(k0 + kk) * N + n0 + (lane & 31)]; }
    LDS_WAIT(); asm volatile("" ::: "memory");
    const int c = lane & 7;
#pragma unroll
    for (int j = 0; j < 4; ++j) { const int n = (lane >> 3) + 8 * j; const LAS float* s = scr + (8 * c) * 33 + n;
        v4u o; o.x = pk2(s[0 * 33], s[1 * 33]); o.y = pk2(s[2 * 33], s[3 * 33]); o.z = pk2(s[4 * 33], s[5 * 33]); o.w = pk2(s[6 * 33], s[7 * 33]);
        *(v4u*)(WT + (size_t)(n0 + n) * K + k0 + 8 * c) = o; }
    LDS_WAIT(); asm volatile("" ::: "memory");
}
__device__ __forceinline__ void rms_row_to_bf16(const float* xrow, const float* gain, bf16* orow, int lane) {
    const f32x4* xr = (const f32x4*)xrow + lane; const f32x4* gr = (const f32x4*)gain + lane;
    f32x4 v[4]; float s = 0.f;
#pragma unroll
    for (int j = 0; j < 4; ++j) { v[j] = xr[64 * j]; s += (v[j].x * v[j].x + v[j].y * v[j].y) + (v[j].z * v[j].z + v[j].w * v[j].w); }
    const float r = 1.0f / sqrtf(wave_sum(s) * (1.f / D) + RMS_EPS);
    v2u* o8 = (v2u*)orow + lane;
#pragma unroll
    for (int j = 0; j < 4; ++j) { const f32x4 g = gr[64 * j]; v2u w; w.x = pk2(v[j].x * r * g.x, v[j].y * r * g.y); w.y = pk2(v[j].z * r * g.z, v[j].w * r * g.w); o8[64 * j] = w; }
}
__device__ __forceinline__ void rowwise_phase(const float* MF, const float* gpost, const float* xin, float* xout, const float* gpre, bf16* XN, int bid, int G) {
    const int tid = opaque_tid(), lane = tid & 63, gw = bid * NWAVES + (tid >> 6), NGW = G * NWAVES;
    for (int row = gw; row < T; row += NGW) {
        const f32x4* mr = (const f32x4*)(MF + (size_t)row * D) + lane; const f32x4* xr = (const f32x4*)(xin + (size_t)row * D) + lane;
        f32x4* xo = (f32x4*)(xout + (size_t)row * D) + lane;
        f32x4 v[4]; float s = 0.f;
#pragma unroll
        for (int j = 0; j < 4; ++j) { v[j] = mr[64 * j]; s += (v[j].x * v[j].x + v[j].y * v[j].y) + (v[j].z * v[j].z + v[j].w * v[j].w); }
        const float r1 = 1.0f / sqrtf(wave_sum(s) * (1.f / D) + RMS_EPS);
        float s2 = 0.f;
#pragma unroll
        for (int j = 0; j < 4; ++j) { const f32x4 g = ((const f32x4*)gpost + lane)[64 * j]; const f32x4 xv = xr[64 * j]; v[j] = xv + v[j] * r1 * g; xo[64 * j] = v[j];
            s2 += (v[j].x * v[j].x + v[j].y * v[j].y) + (v[j].z * v[j].z + v[j].w * v[j].w); }
        if (gpre) {
            const float r2 = 1.0f / sqrtf(wave_sum(s2) * (1.f / D) + RMS_EPS);
            v2u* o8 = (v2u*)(XN + (size_t)row * D) + lane;
#pragma unroll
            for (int j = 0; j < 4; ++j) { const f32x4 g = ((const f32x4*)gpre + lane)[64 * j]; v2u w; w.x = pk2(v[j].x * r2 * g.x, v[j].y * r2 * g.y); w.y = pk2(v[j].z * r2 * g.z, v[j].w * r2 * g.w); o8[64 * j] = w; }
        }
    }
}
__device__ __forceinline__ void act_phase(const bf16* A1, bf16* G1, const float* cw, const float* cb, int bid, int G) {
    const int gtid = bid * 512 + opaque_tid(), NT_ = G * 512;
    constexpr int NCH = FF / 8, NITEM = (T / 16) * NCH;
    for (int it = gtid; it < NITEM; it += NT_) {
        const int strip = it / NCH, ch = it % NCH, t0 = strip * 16, f0 = ch * 8;
        float w0[8], w1[8], w2[8], bb[8];
#pragma unroll
        for (int e = 0; e < 8; ++e) { w0[e] = cw[f0 + e]; w1[e] = cw[FF + f0 + e]; w2[e] = cw[2 * FF + f0 + e]; bb[e] = cb[f0 + e]; }
        v4u p2 = (v4u){0u, 0u, 0u, 0u}, p1 = p2;
        if ((t0 & (S - 1)) != 0) { p2 = *(const v4u*)(A1 + (size_t)(t0 - 2) * FF + f0); p1 = *(const v4u*)(A1 + (size_t)(t0 - 1) * FF + f0); }
#pragma unroll 4
        for (int i = 0; i < 16; ++i) {
            const v4u c = *(const v4u*)(A1 + (size_t)(t0 + i) * FF + f0); const v4u g = *(const v4u*)(G1 + (size_t)(t0 + i) * FF + f0);
            v4u o;
#pragma unroll
            for (int q = 0; q < 4; ++q) {
                const float a0 = bb[2 * q] + w0[2 * q] * bflo(p2[q]) + w1[2 * q] * bflo(p1[q]) + w2[2 * q] * bflo(c[q]);
                const float a1 = bb[2 * q + 1] + w0[2 * q + 1] * bfhi(p2[q]) + w1[2 * q + 1] * bfhi(p1[q]) + w2[2 * q + 1] * bfhi(c[q]);
                o[q] = pk2(pg8::gelu_tanh(a0) * bflo(g[q]), pg8::gelu_tanh(a1) * bfhi(g[q]));
            }
            *(v4u*)(G1 + (size_t)(t0 + i) * FF + f0) = o;
            p2 = p1; p1 = c;
        }
    }
}

namespace att {
constexpr int STAGE = 32768;
__device__ __forceinline__ int crow(int r, int hi) { return (r & 3) + 8 * (r >> 2) + 4 * hi; }
__device__ __forceinline__ void dma_tile(LAS unsigned char* st, const bf16* QK, const bf16* VT, int b, int h, int t, int wid, int lane) {
#pragma unroll
    for (int i = 0; i < 4; ++i) {
        const int p = 4 * wid + i; const bf16* src; int dst;
        if (p < 16) { const int map = p >> 3, ch = p & 7; src = QK + (size_t)(b * S + 64 * t + lane) * 2048 + 1024 + h * 128 + map * 64 + ch * 8; dst = map * 8192 + ch * 1024; }
        else { const int q = p - 16, ch = q >> 1, vh = q & 1; src = VT + (size_t)(h * 128 + vh * 64 + lane) * T + (size_t)b * S + 64 * t + ch * 8; dst = 16384 + ch * 2048 + vh * 1024; }
        __builtin_amdgcn_global_load_lds((const unsigned*)src, (LAS unsigned*)(st + dst), 16, 0, 0);
    }
}
__device__ __forceinline__ bf16x8 pack8(const f32x16& p, int o) {
    v4u w; w.x = pg8::cvt_pk_bf16(p[o + 0], p[o + 1]); w.y = pg8::cvt_pk_bf16(p[o + 2], p[o + 3]); w.z = pg8::cvt_pk_bf16(p[o + 4], p[o + 5]); w.w = pg8::cvt_pk_bf16(p[o + 6], p[o + 7]);
    return __builtin_bit_cast(bf16x8, w);
}
__device__ __forceinline__ void attn_unit(LAS unsigned char* lds, const bf16* QK, const bf16* VT, bf16* O, int b, int h, int qb, int t_lo, float lam, const float* subln, int tid) {
    const int lane = tid & 63, r32 = lane & 31, hi = lane >> 5, wid = __builtin_amdgcn_readfirstlane(tid >> 6);
    const int map = wid >> 2, wq = wid & 3, q0 = qb * 128, qw = q0 + 32 * wq, qpos = qw + r32;
    const float sl2 = __builtin_amdgcn_exp2f(-(float)(h + 1)) * 1.4426950408889634f;
    const bf16* qp = QK + (size_t)(b * S + qpos) * 2048 + h * 128 + map * 64 + hi * 8;
    bf16x8 qr[4];
#pragma unroll
    for (int d0 = 0; d0 < 4; ++d0) qr[d0] = *(const bf16x8*)(qp + 16 * d0);
    f32x16 o[4];
#pragma unroll
    for (int d0 = 0; d0 < 4; ++d0)
#pragma unroll
        for (int r = 0; r < 16; ++r) o[d0][r] = 0.f;
    float m_run = -1e30f, l = 0.f;
    const int NT = (q0 + 128) / 64, n = NT - t_lo;
    const int pk = (r32 & ~12) | ((r32 & 4) << 1) | ((r32 & 8) >> 1);
    const int koff = map * 8192 + hi * 1024 + pk * 16, voff = 16384 + hi * 2048 + r32 * 16;
    dma_tile(lds, QK, VT, b, h, NT - 1, wid, lane);
    if (n > 1) dma_tile(lds + STAGE, QK, VT, b, h, NT - 2, wid, lane);
    int sc = 0, sn = 2 * STAGE;
    for (int i = 0; i < n; ++i) {
        const int t = NT - 1 - i;
        if (i + 1 < n) asm volatile("s_waitcnt vmcnt(4)" ::: "memory"); else asm volatile("s_waitcnt vmcnt(0)" ::: "memory");
        LDS_WAIT(); __syncthreads();
        if (i + 2 < n) dma_tile(lds + sn, QK, VT, b, h, t - 2, wid, lane);
        if (64 * t <= qw + 31) {
            const LAS unsigned char* st = lds + sc;
            f32x16 p0, p1;
#pragma unroll
            for (int r = 0; r < 16; ++r) { p0[r] = 0.f; p1[r] = 0.f; }
#pragma unroll
            for (int d0 = 0; d0 < 4; ++d0) {
                const bf16x8 k0 = *(const LAS bf16x8*)(st + koff + d0 * 2048), k1 = *(const LAS bf16x8*)(st + koff + d0 * 2048 + 512);
                p0 = __builtin_amdgcn_mfma_f32_32x32x16_bf16(k0, qr[d0], p0, 0, 0, 0); p1 = __builtin_amdgcn_mfma_f32_32x32x16_bf16(k1, qr[d0], p1, 0, 0, 0);
            }
            const int relb = 64 * t + 8 * hi - qpos;
            const float fb = sl2 * (float)relb;
#pragma unroll
            for (int r = 0; r < 16; ++r) { const int c = 16 * (r >> 3) + (r & 7); p0[r] += fb + sl2 * (float)c; p1[r] += fb + sl2 * (float)(c + 32); }
            if (64 * t + 63 > qw) {
#pragma unroll
                for (int r = 0; r < 16; ++r) { const int c = 16 * (r >> 3) + (r & 7); if (relb + c > 0) p0[r] = -1e30f; if (relb + c + 32 > 0) p1[r] = -1e30f; }
            }
            float mx = fmaxf(p0[0], p1[0]);
#pragma unroll
            for (int r = 1; r < 16; ++r) mx = fmaxf(mx, fmaxf(p0[r], p1[r]));
            mx = fmaxf(mx, __shfl_xor(mx, 32));
            const float m_new = fmaxf(m_run, mx), alpha = __builtin_amdgcn_exp2f(m_run - m_new); m_run = m_new;
            float ps = 0.f;
#pragma unroll
            for (int r = 0; r < 16; ++r) { p0[r] = __builtin_amdgcn_exp2f(p0[r] - m_new); p1[r] = __builtin_amdgcn_exp2f(p1[r] - m_new); ps += p0[r] + p1[r]; }
            l = l * alpha + ps;
#pragma unroll
            for (int d0 = 0; d0 < 4; ++d0)
#pragma unroll
                for (int r = 0; r < 16; ++r) o[d0][r] *= alpha;
            bf16x8 pf[4]; pf[0] = pack8(p0, 0); pf[1] = pack8(p0, 8); pf[2] = pack8(p1, 0); pf[3] = pack8(p1, 8);
#pragma unroll
            for (int d0 = 0; d0 < 4; ++d0)
#pragma unroll
                for (int s = 0; s < 4; ++s) { const bf16x8 vf = *(const LAS bf16x8*)(st + voff + s * 4096 + d0 * 512); o[d0] = __builtin_amdgcn_mfma_f32_32x32x16_bf16(vf, pf[s], o[d0], 0, 0, 0); }
        }
        sn = sc; sc = (sc == 2 * STAGE) ? 0 : sc + STAGE;
    }
    LDS_WAIT(); __syncthreads();
    l += __shfl_xor(l, 32);
    const float inv = 1.0f / l;
    LAS float* X = (LAS float*)lds;
    if (map == 1) {
#pragma unroll
        for (int d0 = 0; d0 < 4; ++d0)
#pragma unroll
            for (int r = 0; r < 16; ++r) X[(wq * 128 + 32 * d0 + crow(r, hi)) * 32 + r32] = o[d0][r] * inv;
    }
    LDS_WAIT(); __syncthreads();
    if (map == 0) {
        float ss = 0.f;
#pragma unroll
        for (int d0 = 0; d0 < 4; ++d0)
#pragma unroll
            for (int r = 0; r < 16; ++r) { const float v = o[d0][r] * inv - lam * X[(wq * 128 + 32 * d0 + crow(r, hi)) * 32 + r32]; o[d0][r] = v; ss += v * v; }
        ss += __shfl_xor(ss, 32);
        const float rs = 0.8f / sqrtf(ss * (1.f / 128.f) + RMS_EPS);
        bf16* op = O + (size_t)(b * S + qpos) * D + h * 128 + 4 * hi;
#pragma unroll
        for (int d0 = 0; d0 < 4; ++d0)
#pragma unroll
            for (int r4 = 0; r4 < 4; ++r4) { const int vd0 = 32 * d0 + 8 * r4; const f32x4 g = *(const f32x4*)(subln + vd0 + 4 * hi);
                v2u w; w.x = pk2(o[d0][4 * r4] * rs * g.x, o[d0][4 * r4 + 1] * rs * g.y); w.y = pk2(o[d0][4 * r4 + 2] * rs * g.z, o[d0][4 * r4 + 3] * rs * g.w);
                *(v2u*)(op + vd0) = w; }
    }
}
__device__ __forceinline__ void attn_phase(LAS unsigned char* lds, const bf16* QK, const bf16* VT, bf16* O, const float* lq1, const float* lk1, const float* lq2, const float* lk2,
                                           const float* subln, unsigned* qctr, const unsigned* nrm, int tid) {
    const int lane = tid & 63;
    const float d1 = wave_sum(lq1[lane] * lk1[lane]), d2 = wave_sum(lq2[lane] * lk2[lane]);
    const float lam = expf(d1) - expf(d2) + 0.2f;
    LAS unsigned* su = (LAS unsigned*)(lds + 3 * STAGE);
    for (;;) {
        if (tid == 0) su[0] = atomicAdd(qctr, 1u);
        LDS_WAIT(); __syncthreads();
        const unsigned u = su[0];
        if (u >= 2048u) break;
        const int qb = 127 - (int)(u >> 4), bh = (int)(u & 15), b = bh >> 3, h = bh & 7;
        float Bm = 0.f;
#pragma unroll
        for (int mp = 0; mp < 2; ++mp) { const int g = b * 64 + h * 4 + mp * 2;
            const float qn = __builtin_bit_cast(float, nrm[g]) + __builtin_bit_cast(float, nrm[g + 1]), kn = __builtin_bit_cast(float, nrm[g + 32]) + __builtin_bit_cast(float, nrm[g + 33]);
            Bm = fmaxf(Bm, sqrtf(qn) * sqrtf(kn) * 1.03f); }
        const float sl2 = __builtin_amdgcn_exp2f(-(float)(h + 1)) * 1.4426950408889634f;
        const float Dq = (2.f * Bm + 37.f - __builtin_amdgcn_logf(1.f - __builtin_amdgcn_exp2f(-sl2))) / sl2 + 1.f;
        const int kdrop = qb * 128 - (int)fminf(Dq, 1.0e8f);
        const int t_lo = (kdrop >= 63) ? (kdrop - 63) / 64 + 1 : 0;
        attn_unit(lds, QK, VT, O, b, h, qb, t_lo, lam, subln, tid);
        VM_WAIT();
    }
}
}

__device__ __forceinline__ void sgu_phase(LAS unsigned char* lds, bf16* VT2, const bf16* U, bf16* Y, const bf16* Wsb, const float* ln_g, const float* ln_b, const float* b_s, int tid, int bid, int nblk) {
    const int lane = tid & 63, r32 = lane & 31, hi = lane >> 5, wid = __builtin_amdgcn_readfirstlane(tid >> 6);
    LAS float* sS = (LAS float*)lds;
    LAS float* sMu = (LAS float*)(lds + 8192); LAS float* sRs = sMu + 128;
    for (int chunk = bid; chunk < T / 128; chunk += nblk) {
        const int tok0 = chunk * 128, tg = tid & 15, cp = tid >> 4;
        bf16* vp = VT2 + (size_t)(cp * 64) * T + tok0 + 8 * tg;
        float sm[8], sq[8];
#pragma unroll
        for (int j = 0; j < 8; ++j) { sm[j] = 0.f; sq[j] = 0.f; }
#pragma unroll 4
        for (int i = 0; i < 64; ++i) { const v4u v = *(const v4u*)(vp + (size_t)i * T);
#pragma unroll
            for (int q = 0; q < 4; ++q) { const float a = bflo(v[q]), c = bfhi(v[q]); sm[2 * q] += a; sq[2 * q] += a * a; sm[2 * q + 1] += c; sq[2 * q + 1] += c * c; } }
#pragma unroll
        for (int j = 0; j < 8; ++j) { sm[j] += __shfl_xor(sm[j], 16); sm[j] += __shfl_xor(sm[j], 32); sq[j] += __shfl_xor(sq[j], 16); sq[j] += __shfl_xor(sq[j], 32); }
        if (lane < 16) {
#pragma unroll
            for (int j = 0; j < 8; ++j) { sS[(wid * 128 + 8 * tg + j) * 2] = sm[j]; sS[(wid * 128 + 8 * tg + j) * 2 + 1] = sq[j]; } }
        LDS_WAIT(); __syncthreads();
        if (tid < 128) { float s = 0.f, q = 0.f;
#pragma unroll
            for (int w = 0; w < 8; ++w) { s += sS[(w * 128 + tid) * 2]; q += sS[(w * 128 + tid) * 2 + 1]; }
            const float mu = s * (1.f / E2), var = fmaxf(q * (1.f / E2) - mu * mu, 0.f); sMu[tid] = mu; sRs[tid] = 1.0f / sqrtf(var + LN_EPS); }
        LDS_WAIT(); __syncthreads();
        float mu[8], rs[8];
#pragma unroll
        for (int j = 0; j < 8; ++j) { mu[j] = sMu[8 * tg + j]; rs[j] = sRs[8 * tg + j]; }
#pragma unroll 4
        for (int i = 0; i < 64; ++i) { const float g = ln_g[cp * 64 + i], be = ln_b[cp * 64 + i]; const v4u v = *(const v4u*)(vp + (size_t)i * T); v4u o;
#pragma unroll
            for (int q = 0; q < 4; ++q) o[q] = pk2((bflo(v[q]) - mu[2 * q]) * rs[2 * q] * g + be, (bfhi(v[q]) - mu[2 * q + 1]) * rs[2 * q + 1] * g + be);
            *(v4u*)(vp + (size_t)i * T) = o; }
        VM_WAIT(); __syncthreads();
        const int g = wid;
#pragma unroll 1
        for (int cb = 0; cb < 8; ++cb) {
            f32x16 acc[4];
#pragma unroll
            for (int nb = 0; nb < 4; ++nb)
#pragma unroll
                for (int r = 0; r < 16; ++r) acc[nb][r] = 0.f;
            const bf16* ap = VT2 + (size_t)(g * 256 + cb * 32 + r32) * T + tok0 + 8 * hi;
            const bf16* wp = Wsb + ((size_t)g * 128 + r32) * 128 + 8 * hi;
#pragma unroll
            for (int ks = 0; ks < 8; ++ks) {
                const bf16x8 a = *(const bf16x8*)(ap + 16 * ks);
#pragma unroll
                for (int nb = 0; nb < 4; ++nb) if (nb >= (ks >> 1)) { const bf16x8 w = *(const bf16x8*)(wp + (size_t)(32 * nb) * 128 + 16 * ks); acc[nb] = __builtin_amdgcn_mfma_f32_32x32x16_bf16(a, w, acc[nb], 0, 0, 0); }
            }
#pragma unroll
            for (int nb = 0; nb < 4; ++nb) { const int t = 32 * nb + r32; const float bs = b_s[g * 128 + t];
                const size_t ro = (size_t)(tok0 + t) * E2 + g * 256 + cb * 32 + 4 * hi;
#pragma unroll
                for (int r4 = 0; r4 < 4; ++r4) { const v2u uu = *(const v2u*)(U + ro + 8 * r4); v2u w;
                    w.x = pk2(bflo(uu.x) * (acc[nb][4 * r4] + bs), bfhi(uu.x) * (acc[nb][4 * r4 + 1] + bs)); w.y = pk2(bflo(uu.y) * (acc[nb][4 * r4 + 2] + bs), bfhi(uu.y) * (acc[nb][4 * r4 + 3] + bs));
                    *(v2u*)(Y + ro + 8 * r4) = w; } }
        }
        __syncthreads();
    }
}

struct Args { const float* in[22]; float* out; unsigned char* ws; };

#define GEMM(EPI, Aptr, Bptr, M_, N_, K_, ...) do { pg8::Gemm g_{(const pg8::bf16_t*)(Aptr), (const pg8::bf16_t*)(Bptr), (M_), (N_), (K_)}; pg8::StaticOrder S_; S_.init((M_), (N_), G, bid); \
    EPI E_{__VA_ARGS__}; pg8::gemm_phase<EPI, pg8::StaticOrder, true, true>(lds, g_, S_, E_); } while (0)

__global__ void __launch_bounds__(512) mega_fwd(Args a) {
    extern __shared__ __attribute__((aligned(16))) unsigned char lds_raw[];
    LAS unsigned char* lds = (LAS unsigned char*)lds_raw;
    cg::grid_group grid = cg::this_grid();
    const int tid = threadIdx.x, lane = tid & 63, wid = __builtin_amdgcn_readfirstlane(tid >> 6), bid = blockIdx.x, G = gridDim.x;
    const int gw = bid * NWAVES + wid, NGW = G * NWAVES, gtid = bid * 512 + tid, NTHR = G * 512;
    unsigned char* ws = a.ws;
    bf16 *Wqkv = (bf16*)(ws + WS_WQKV), *Wo = (bf16*)(ws + WS_WO), *Win = (bf16*)(ws + WS_WIN), *Wout = (bf16*)(ws + WS_WOUT), *Wup = (bf16*)(ws + WS_WUP), *Wdn = (bf16*)(ws + WS_WDN), *Wsb = (bf16*)(ws + WS_WSB);
    bf16 *XN = (bf16*)(ws + WS_XN), *QK = (bf16*)(ws + WS_QK), *VT = (bf16*)(ws + WS_VT), *Ob = (bf16*)(ws + WS_O), *A1 = (bf16*)(ws + WS_A1), *G1 = (bf16*)(ws + WS_G1);
    bf16 *U = (bf16*)(ws + WS_U), *VT2 = (bf16*)(ws + WS_VT2), *Y = (bf16*)(ws + WS_Y);
    float* MF = (float*)(ws + WS_MF); float* out = a.out;
    const float* x = a.in[0];

    {
        LAS float* scr = (LAS float*)(lds + wid * 16384);
        constexpr int I0 = 16 * 96, I1 = 16 * 32, I2 = 16 * 128, I3 = 32 * 32, I4 = 16 * 176, I5 = 44 * 32;
        constexpr int NIT = I0 + I1 + I2 + I3 + 2 * I4 + 2 * I5;
        for (int it = gw; it < NIT; it += NGW) {
            int r = it;
            if (r < I0) { p0_transpose_item(a.in[1], D, 3 * D, Wqkv, scr, r, lane); continue; } r -= I0;
            if (r < I1) { p0_transpose_item(a.in[7], D, D, Wo, scr, r, lane); continue; } r -= I1;
            if (r < I2) { p0_transpose_item(a.in[8], D, 2 * E2, Win, scr, r, lane); continue; } r -= I2;
            if (r < I3) { p0_transpose_item(a.in[13], E2, D, Wout, scr, r, lane); continue; } r -= I3;
            if (r < I4) { p0_transpose_item(a.in[18], D, 2 * FF, Wup, scr, r, lane); continue; } r -= I4;
            if (r < I4) { p0_transpose_item(a.in[18] + (size_t)D * 2 * FF, D, 2 * FF, Wup + (size_t)2 * FF * D, scr, r, lane); continue; } r -= I4;
            if (r < I5) { p0_transpose_item(a.in[21], FF, D, Wdn, scr, r, lane); continue; } r -= I5;
            p0_transpose_item(a.in[21] + (size_t)FF * D, FF, D, Wdn + (size_t)D * FF, scr, r, lane);
        }
        for (int i = gtid; i < 8 * 128 * 128; i += NTHR) { const int s = i & 127, t = (i >> 7) & 127; Wsb[i] = (bf16)(s <= t ? f2bf(a.in[11][i]) : 0u); }
        for (int m = gw; m < T; m += NGW) rms_row_to_bf16(x + (size_t)m * D, a.in[14], XN + (size_t)m * D, lane);
    }
    __syncthreads(); grid.sync();
    GEMM(pg8::EpiQK, XN, Wqkv, T, 2 * D, D, QK, 2 * D, D, C2, (unsigned*)(ws + WS_CTL) + CW_NRM, S);
    GEMM(pg8::EpiB<0>, Wqkv + (size_t)2 * D * D, XN, D, T, D, VT, T, 0, 0, 0, 1.f);
    grid.sync();
    att::attn_phase(lds, QK, VT, Ob, a.in[2], a.in[3], a.in[4], a.in[5], a.in[6], (unsigned*)(ws + WS_CTL) + CW_ATTQ, (const unsigned*)(ws + WS_CTL) + CW_NRM, opaque_tid());
    __syncthreads(); grid.sync();
    GEMM(pg8::EpiF, Ob, Wo, T, D, D, MF, D);
    grid.sync();
    rowwise_phase(MF, a.in[15], x, out, a.in[16], XN, bid, G);
    grid.sync();
#pragma unroll 1
    for (int L = 0; L < 2; ++L) {
        GEMM(pg8::EpiB<0>, XN, Wup + (size_t)L * 2 * FF * D, T, 2 * FF, D, A1, FF, FF, (size_t)(WS_G1 - WS_A1) / 2, 0, 1.f);
        grid.sync();
        act_phase(A1, G1, a.in[19] + (size_t)L * 3 * FF, a.in[20] + (size_t)L * FF, bid, G);
        grid.sync();
        GEMM(pg8::EpiF, G1, Wdn + (size_t)L * D * FF, T, D, FF, MF, D);
        grid.sync();
        if (L == 0) rowwise_phase(MF, a.in[17], out, out, a.in[14] + D, XN, bid, G);
        else        rowwise_phase(MF, a.in[17] + D, out, out, nullptr, XN, bid, G);
        if (L == 1) break;
        grid.sync();
        GEMM(pg8::EpiB<1>, XN, Win, T, E2, D, U, E2, 0, 0, 0, 1.f);
        GEMM(pg8::EpiB<1>, Win + (size_t)E2 * D, XN, E2, T, D, VT2, T, 0, 0, 0, 1.f);
        grid.sync();
        sgu_phase(lds, VT2, U, Y, Wsb, a.in[9], a.in[10], a.in[12], opaque_tid(), bid, G);
        grid.sync();
        GEMM(pg8::EpiF, Y, Wout, T, D, E2, MF, D);
        grid.sync();
        rowwise_phase(MF, a.in[15] + D, out, out, a.in[16] + D, XN, bid, G);
        grid.sync();
    }
}

extern "C" void kernel_launch(void* const* d_in, const int* in_sizes, int n_in, void* d_out, int out_size, void* d_ws, size_t ws_size, hipStream_t stream) {
    static int grid = 0;
    if (grid == 0) {
        if (n_in != 22 || out_size != T * D || ws_size < WS_END) { fprintf(stderr, "kernel_launch: unexpected shapes (n_in %d out %d ws %zu)\n", n_in, out_size, ws_size); grid = -1; return; }
        int dev = 0, cus = 0, per_cu = 0;
        hipGetDevice(&dev); hipDeviceGetAttribute(&cus, hipDeviceAttributeMultiprocessorCount, dev);
        hipFuncSetAttribute((const void*)mega_fwd, hipFuncAttributeMaxDynamicSharedMemorySize, LDS_BYTES);
        if (hipOccupancyMaxActiveBlocksPerMultiprocessor(&per_cu, (const void*)mega_fwd, 512, LDS_BYTES) != hipSuccess || per_cu < 1) per_cu = 1;
        (void)hipGetLastError();
        grid = cus * per_cu;
    }
    if (grid < 0) return;
    hipMemsetAsync((char*)d_ws + WS_CTL, 0, 4096, stream);
    Args a{};
    for (int i = 0; i < 22; ++i) a.in[i] = (const float*)d_in[i];
    a.out = (float*)d_out; a.ws = (unsigned char*)d_ws;
    void* args[] = {&a};
    hipError_t e = hipLaunchCooperativeKernel((const void*)mega_fwd, dim3(grid), dim3(512), args, LDS_BYTES, stream);
    if (e != hipSuccess) fprintf(stderr, "cooperative launch failed: %s (grid %d)\n", hipGetErrorString(e), grid);
}
```
